# Optimizing an MI355X kernel written in HIP

```python
import jax, jax.numpy as jnp
from jax import lax
import numpy as np

D_MODEL = 1024
BATCH = 8
SEQ = 4096
DEPTH = 2

N_HEADS = 16
HEAD_DIM = 64
ATTN_WIDTH = N_HEADS * HEAD_DIM
DILATED_PATTERNS = ((128, 1), (512, 4), (2048, 16))
N_GROUPS = len(DILATED_PATTERNS)
FOX_Q_BLOCK = 128
ROT_DIM = HEAD_DIM // 4
ROPE_THETA = 500000.0
D_FF = -(-8 * D_MODEL // (3 * 256)) * 256
RMS_EPS = 1e-6
NEG_INF = -1e30
N_MIXERS = 2
N_A_LAYERS = (DEPTH + 1) // 2
N_B_LAYERS = DEPTH // 2

kernel_name = "hybrid_dilated_fox_swiglu"


def rmsnorm(x, g):
    xf = x.astype(jnp.float32)
    y = xf * lax.rsqrt(jnp.mean(xf * xf, axis=-1, keepdims=True) + RMS_EPS) * g.astype(jnp.float32)
    return y.astype(x.dtype)


def partial_rotary(t, pos):
    half = ROT_DIM // 2
    inv_freq = ROPE_THETA ** (-jnp.arange(half, dtype=jnp.float32) * 2.0 / ROT_DIM)
    ang = pos[:, None] * inv_freq[None, :]
    cos = jnp.cos(ang)[None, :, None, :]
    sin = jnp.sin(ang)[None, :, None, :]
    t1 = t[..., :half].astype(jnp.float32)
    t2 = t[..., half:ROT_DIM].astype(jnp.float32)
    rot = jnp.concatenate([t1 * cos - t2 * sin, t2 * cos + t1 * sin], axis=-1).astype(t.dtype)
    return jnp.concatenate([rot, t[..., ROT_DIM:]], axis=-1)


def dilated_band_attention(q, k, v, dil, steps):
    B, S, H, D = q.shape
    L = S // dil
    blk = steps
    nb = -(-L // blk)
    Lp = nb * blk

    def by_stride(t):
        t = t.reshape(B, L, dil, H, D).transpose(0, 2, 1, 3, 4)
        return jnp.pad(t, ((0, 0), (0, 0), (0, Lp - L), (0, 0), (0, 0)))

    def band(t):
        tp = jnp.pad(t, ((0, 0), (0, 0), (blk, 0), (0, 0), (0, 0))).reshape(B, dil, nb + 1, blk, H, D)
        return jnp.concatenate([tp[:, :, :-1], tp[:, :, 1:]], axis=3)

    qb = by_stride(q).reshape(B, dil, nb, blk, H, D)
    kb = band(by_stride(k))
    vb = band(by_stride(v))

    s = jnp.einsum('bcnihd,bcnjhd->bcnhij', qb, kb).astype(jnp.float32) * (D ** -0.5)
    i = jnp.arange(blk)[:, None]
    j = jnp.arange(2 * blk)[None, :]
    diff = i + blk - j
    key_step = (jnp.arange(nb)[:, None] - 1) * blk + jnp.arange(2 * blk)[None, :]
    valid = ((diff >= 0) & (diff <= steps))[None, :, :] & (key_step >= 0)[:, None, :]
    s = jnp.where(valid[None, None, :, None, :, :], s, NEG_INF)

    m = jnp.max(s, axis=-1, keepdims=True)
    p = jnp.exp(s - m)
    den = jnp.sum(p, axis=-1, keepdims=True)
    o = jnp.einsum('bcnhij,bcnjhd->bcnihd', p / den, vb.astype(jnp.float32))
    lse = (m + jnp.log(den))[..., 0]

    o = o.reshape(B, dil, Lp, H, D)[:, :, :L].transpose(0, 2, 1, 3, 4).reshape(B, S, H, D)
    lse = lse.transpose(0, 1, 2, 4, 3).reshape(B, dil, Lp, H)[:, :, :L].transpose(0, 2, 1, 3).reshape(B, S, H)
    return o, lse


def dilated_mixer(h, w_in, w_out):
    B, S, _ = h.shape
    proj = (h @ w_in).reshape(B, S, N_GROUPS, 3, N_HEADS, HEAD_DIM)
    pos = jnp.arange(S, dtype=jnp.float32)
    outs, lses = [], []
    for g, (window, dil) in enumerate(DILATED_PATTERNS):
        q = partial_rotary(proj[:, :, g, 0], pos)
        k = partial_rotary(proj[:, :, g, 1], pos)
        v = proj[:, :, g, 2]
        o, lse = dilated_band_attention(q, k, v, dil, window // dil)
        outs.append(o)
        lses.append(lse)
    wts = jax.nn.softmax(jnp.stack(lses, axis=0), axis=0)
    o = jnp.einsum('gbsh,gbshd->bshd', wts, jnp.stack(outs, axis=0))
    return o.reshape(B, S, ATTN_WIDTH).astype(h.dtype) @ w_out


def forgetting_mixer(h, w_in, b_f, w_out):
    B, S, _ = h.shape
    proj = h @ w_in
    qkv = proj[..., :3 * ATTN_WIDTH].reshape(B, S, 3, N_HEADS, HEAD_DIM)
    q, k, v = qkv[:, :, 0], qkv[:, :, 1], qkv[:, :, 2]
    log_f = jax.nn.log_sigmoid(proj[..., 3 * ATTN_WIDTH:].astype(jnp.float32) + b_f.astype(jnp.float32))
    c = lax.cumsum(log_f, axis=1)
    nq = S // FOX_Q_BLOCK
    qb = q.reshape(B, nq, FOX_Q_BLOCK, N_HEADS, HEAD_DIM).transpose(1, 0, 2, 3, 4)
    cqb = c.reshape(B, nq, FOX_Q_BLOCK, N_HEADS).transpose(1, 0, 3, 2)
    ck = c.transpose(0, 2, 1)
    key_pos = jnp.arange(S)
    vf = v.astype(jnp.float32)
    scale = HEAD_DIM ** -0.5

    def block(args):
        qi, ci, n = args
        s = jnp.einsum('bihd,bjhd->bhij', qi, k).astype(jnp.float32) * scale
        s = s + ci[..., None] - ck[:, :, None, :]
        qpos = n * FOX_Q_BLOCK + jnp.arange(FOX_Q_BLOCK)
        s = jnp.where(key_pos[None, :] <= qpos[:, None], s, NEG_INF)
        p = jax.nn.softmax(s, axis=-1)
        return jnp.einsum('bhij,bjhd->bihd', p, vf)

    o = lax.map(block, (qb, cqb, jnp.arange(nq)))
    o = o.transpose(1, 0, 2, 3, 4).reshape(B, S, ATTN_WIDTH).astype(h.dtype)
    return o @ w_out


def swiglu(h, w_gu, w_down):
    gu = h @ w_gu
    g, u = gu[..., :D_FF], gu[..., D_FF:]
    return (jax.nn.silu(g) * u) @ w_down


def setup_inputs(seed: int = 0) -> dict:
    key = jax.random.key(seed)
    ks = jax.random.split(key, 13)
    f32 = jnp.float32
    x = jax.random.normal(ks[0], (BATCH, SEQ, D_MODEL), f32)
    a_norm = 1.0 + 0.02 * jax.random.normal(ks[1], (N_A_LAYERS, D_MODEL), f32)
    a_w_in = jax.random.normal(ks[2], (N_A_LAYERS, D_MODEL, N_GROUPS * 3 * ATTN_WIDTH), f32) * D_MODEL ** -0.5
    a_w_out = jax.random.normal(ks[3], (N_A_LAYERS, ATTN_WIDTH, D_MODEL), f32) * ATTN_WIDTH ** -0.5
    b_norm = 1.0 + 0.02 * jax.random.normal(ks[4], (N_B_LAYERS, D_MODEL), f32)
    b_w_in = jax.random.normal(ks[5], (N_B_LAYERS, D_MODEL, 3 * ATTN_WIDTH + N_HEADS), f32) * D_MODEL ** -0.5
    b_f = jnp.linspace(1.0, 6.0, N_HEADS, dtype=f32)[None, :] + 0.1 * jax.random.normal(ks[6], (N_B_LAYERS, N_HEADS), f32)
    b_w_out = jax.random.normal(ks[7], (N_B_LAYERS, ATTN_WIDTH, D_MODEL), f32) * ATTN_WIDTH ** -0.5
    ffn_norm = 1.0 + 0.02 * jax.random.normal(ks[8], (DEPTH, D_MODEL), f32)
    ffn_w_gu = jax.random.normal(ks[9], (DEPTH, D_MODEL, 2 * D_FF), f32) * D_MODEL ** -0.5
    ffn_w_down = jax.random.normal(ks[10], (DEPTH, D_FF, D_MODEL), f32) * D_FF ** -0.5
    final_norm = 1.0 + 0.02 * jax.random.normal(ks[11], (D_MODEL,), f32)
    return {"x": x, "a_norm": a_norm, "a_w_in": a_w_in, "a_w_out": a_w_out,
            "b_norm": b_norm, "b_w_in": b_w_in, "b_f": b_f, "b_w_out": b_w_out,
            "ffn_norm": ffn_norm, "ffn_w_gu": ffn_w_gu, "ffn_w_down": ffn_w_down,
            "final_norm": final_norm}


def reference(x, a_norm, a_w_in, a_w_out, b_norm, b_w_in, b_f, b_w_out,
              ffn_norm, ffn_w_gu, ffn_w_down, final_norm):
    h = x
    for i in range(DEPTH):
        j = i // N_MIXERS
        if i % N_MIXERS == 0:
            h = h + dilated_mixer(rmsnorm(h, a_norm[j]), a_w_in[j], a_w_out[j])
        else:
            h = h + forgetting_mixer(rmsnorm(h, b_norm[j]), b_w_in[j], b_f[j], b_w_out[j])
        h = h + swiglu(rmsnorm(h, ffn_norm[i]), ffn_w_gu[i], ffn_w_down[i])
    return rmsnorm(h, final_norm)
```

```cpp
#include <hip/hip_runtime.h>
#include <hip/hip_cooperative_groups.h>
#include <cstdio>
#include <cstdint>
namespace cg = cooperative_groups;

constexpr int NB = 8, SEQ = 4096, DM = 1024, MT = NB * SEQ, NH = 16, HD = 64, FF = 2816;
constexpr float RMS_EPS = 1e-6f;
constexpr float LOG2E = 1.4426950408889634f;
constexpr float QSCALE = 0.125f * LOG2E;
#define LAS __attribute__((address_space(3)))
#define GAS __attribute__((address_space(1)))

namespace pg8 {
#define PG8_LAS __attribute__((address_space(3)))
typedef unsigned short bf16_t;
typedef short bf16x8 __attribute__((ext_vector_type(8)));
typedef float f32x4 __attribute__((ext_vector_type(4)));
typedef unsigned u32x4 __attribute__((ext_vector_type(4)));
constexpr int BM = 256, BK = 64, HALF = 128, HTB = HALF * BK * 2  , STAGE_BYTES = 8 * HTB, NXCD = 8, WGM = 8;

__host__ __device__ __forceinline__ int lds_byte(int r, int c) { const int st = (r >> 4) * 2 + (c >> 5), rr = r & 15, cc = c & 31, ob = rr * 64 + cc * 2; return st * 1024 + (ob ^ (((ob >> 9) & 1) << 5)); }
__host__ __device__ __forceinline__ void stage_rc(int b, int& R, int& C) { const int st = b / 1024, sb = b % 1024, swz = sb ^ (((sb >> 9) & 1) << 5); R = (st >> 1) * 16 + swz / 64; C = (st & 1) * 32 + (swz % 64) / 2; }
__host__ __device__ __forceinline__ int perm32(int rho) { const int n = rho >> 4, i = rho & 15; return 8 * (i >> 2) + 4 * n + (i & 3); }

struct Unit { int pm, pn; };
struct Gemm { const GAS bf16_t* A; const GAS bf16_t* Bt; int M, N, K, adil, bdil; };
__device__ __forceinline__ int perm_tile_row(int tile, int dil) { const int rho0 = tile * 256, b = rho0 >> 12, w = rho0 & 4095, L = 4096 / dil, c = w / L, i0 = w % L; return b * 4096 + i0 * dil + c; }

struct StaticOrder {
    int nM, nN, nwg, G, c;
    __host__ __device__ void init(int M, int N, int G_, int c_) { nM = M / BM; nN = N / BM; nwg = nM * nN; G = G_; c = c_; }
    __host__ __device__ bool next(int i, Unit& u) const {
        const long L = (long)i * G + c; if (L >= nwg) return false;
        int wgid = (int)L; { const int q = nwg / NXCD, r = nwg % NXCD, xcd = wgid % NXCD, off = wgid / NXCD; wgid = (xcd < r ? xcd * (q + 1) : r * (q + 1) + (xcd - r) * q) + off; }
        const int nig = WGM * nN, gid = wgid / nig, fm = gid * WGM, gsz = (nM - fm) < WGM ? (nM - fm) : WGM;
        u.pm = fm + ((wgid % nig) % gsz); u.pn = (wgid % nig) / gsz; return true;
    }
    __device__ __forceinline__ void a_ready(const Unit&) const {}
    __device__ __forceinline__ void done(const Unit&) const {}
};

typedef float f32x2 __attribute__((ext_vector_type(2))); typedef __bf16 bf16x2v __attribute__((ext_vector_type(2)));
__device__ __forceinline__ unsigned cvt_pk_bf16(float lo, float hi) { const f32x2 v = {lo, hi}; const bf16x2v b = __builtin_convertvector(v, bf16x2v); return __builtin_bit_cast(unsigned, b); }
typedef unsigned u32x2 __attribute__((ext_vector_type(2)));
__device__ __forceinline__ u32x4 pack8(const f32x4 a, const f32x4 b) { u32x4 w; w.x = cvt_pk_bf16(a[0], a[1]); w.y = cvt_pk_bf16(a[2], a[3]); w.z = cvt_pk_bf16(b[0], b[1]); w.w = cvt_pk_bf16(b[2], b[3]); return w; }
__device__ __forceinline__ float row_rs(const GAS float* ss, int row, int fq) {
    const f32x4 p = *(const GAS f32x4*)(ss + (size_t)row * 16 + 4 * fq); float t = (p[0] + p[1]) + (p[2] + p[3]);
    t += __shfl_xor(t, 16); t += __shfl_xor(t, 32); return __builtin_amdgcn_rsqf(t * (1.0f / 1024.0f) + 1e-6f);
}

__device__ __forceinline__ float fq_sum(float t) {
    auto a = __builtin_amdgcn_permlane16_swap(__float_as_uint(t), __float_as_uint(t), false, false); t = __uint_as_float(a[0]) + __uint_as_float(a[1]);
    auto b = __builtin_amdgcn_permlane32_swap(__float_as_uint(t), __float_as_uint(t), false, false); return __uint_as_float(b[0]) + __uint_as_float(b[1]);
}
__device__ __forceinline__ void rows_rs8(const GAS float* ss, int row0  , int fq, float (&rr)[2][4]) {
    f32x4 p[2][4];
#pragma unroll
    for (int ai = 0; ai < 2; ++ai)
#pragma unroll
        for (int m = 0; m < 4; ++m) p[ai][m] = *(const GAS f32x4*)(ss + (size_t)(row0 + ai * HALF + m * 16) * 16 + 4 * fq);
    asm volatile("" :: "v"(p[0][0]), "v"(p[0][1]), "v"(p[0][2]), "v"(p[0][3]), "v"(p[1][0]), "v"(p[1][1]), "v"(p[1][2]), "v"(p[1][3]));
#pragma unroll
    for (int ai = 0; ai < 2; ++ai)
#pragma unroll
        for (int m = 0; m < 4; ++m) { float t = (p[ai][m][0] + p[ai][m][1]) + (p[ai][m][2] + p[ai][m][3]);
            t = fq_sum(t); rr[ai][m] = __builtin_amdgcn_rsqf(t * (1.0f / 1024.0f) + 1e-6f); }
}

struct EpiQK0 {
    static constexpr bool PERM = true, AFTER_DRAIN = false;
    GAS bf16_t* out; const GAS float* rsp; const GAS float* rot; int lgd;
    __device__ __forceinline__ void operator()(const f32x4 (&acc)[2][2][4][2], const Unit& u, int wr, int wc, int fr, int fq) const {
        const int col0 = u.pn * BM + wc * 32 + 8 * fq; const bool rotw = (wc & 1) == 0; const float qs = (u.pn < 4) ? 0.125f * 1.4426950408889634f : 1.0f;
        const int lgL = 12 - lgd, Lm = (1 << lgL) - 1; const float sgn = (fq == 0) ? -1.0f : 1.0f; const bool rl = fq < 2;
        float rr[2][4];
#pragma unroll
        for (int ai = 0; ai < 2; ++ai)
#pragma unroll
            for (int m = 0; m < 4; ++m) rr[ai][m] = rsp[u.pm * BM + ai * HALF + wr * 64 + m * 16 + fr];
        asm volatile("" :: "v"(rr[0][0]), "v"(rr[0][1]), "v"(rr[0][2]), "v"(rr[0][3]), "v"(rr[1][0]), "v"(rr[1][1]), "v"(rr[1][2]), "v"(rr[1][3]));
#pragma unroll
        for (int ai = 0; ai < 2; ++ai)
#pragma unroll
            for (int m = 0; m < 4; ++m) rr[ai][m] *= qs;
#pragma unroll
        for (int ai = 0; ai < 2; ++ai)
#pragma unroll
            for (int mp = 0; mp < 2; ++mp) {
                f32x4 cs[2][4];
                if (rotw) {
#pragma unroll
                    for (int mm = 0; mm < 2; ++mm) { const int rho = u.pm * BM + ai * HALF + wr * 64 + (2 * mp + mm) * 16 + fr, w = rho & 4095, s = ((w & Lm) << lgd) + (w >> lgL);
                        const GAS f32x4* tp = (const GAS f32x4*)(rot + (size_t)s * 16);
#pragma unroll
                        for (int i = 0; i < 4; ++i) cs[mm][i] = tp[i]; }
                    asm volatile("" :: "v"(cs[0][0]), "v"(cs[0][1]), "v"(cs[0][2]), "v"(cs[0][3]), "v"(cs[1][0]), "v"(cs[1][1]), "v"(cs[1][2]), "v"(cs[1][3])); }
#pragma unroll
                for (int mm = 0; mm < 2; ++mm) { const int m = 2 * mp + mm;
                    const int rho = u.pm * BM + ai * HALF + wr * 64 + m * 16 + fr; const float r = rr[ai][m];
#pragma unroll
                    for (int bj = 0; bj < 2; ++bj) { f32x4 v[2];
#pragma unroll
                        for (int n = 0; n < 2; ++n) { v[n] = acc[ai][bj][m][n] * r;
                            if (rotw) { const f32x4 ca = cs[mm][2 * n], cb = cs[mm][2 * n + 1]; f32x4 p;
#pragma unroll
                                for (int j = 0; j < 4; ++j) p[j] = __shfl_xor(v[n][j], 16);
                                if (rl) { v[n][0] = v[n][0] * ca[0] + sgn * p[0] * ca[1]; v[n][1] = v[n][1] * ca[2] + sgn * p[1] * ca[3];
                                          v[n][2] = v[n][2] * cb[0] + sgn * p[2] * cb[1]; v[n][3] = v[n][3] * cb[2] + sgn * p[3] * cb[3]; } } }
                        *(GAS u32x4*)(out + (size_t)rho * 2048 + col0 + bj * HALF) = pack8(v[0], v[1]); }
                }
            }
    }
};
struct EpiVT {
    static constexpr bool PERM = true, AFTER_DRAIN = false;
    GAS bf16_t* vt; const GAS float* rsp; const GAS float* ss;
    __device__ __forceinline__ void operator()(const f32x4 (&acc)[2][2][4][2], const Unit& u, int wr, int wc, int fr, int fq) const {
        const int rho0 = u.pn * BM + wc * 32 + 8 * fq; float rt = 0.f;
        if (!rsp) {
            const int tok = rho0 + (fr >> 3) * HALF + (fr & 7); const GAS f32x4* p = (const GAS f32x4*)(ss + (size_t)tok * 16);
            const f32x4 a = p[0], b = p[1], c = p[2], d = p[3];
            const float t = ((a[0] + a[1]) + (a[2] + a[3])) + ((b[0] + b[1]) + (b[2] + b[3])) + ((c[0] + c[1]) + (c[2] + c[3])) + ((d[0] + d[1]) + (d[2] + d[3]));
            rt = __builtin_amdgcn_rsqf(t * (1.0f / 1024.0f) + 1e-6f); }
        const int b = rho0 >> 12, w = rho0 & 4095, lb = (fq << 4);
#pragma unroll
        for (int bj = 0; bj < 2; ++bj) { float sc[8];
            if (rsp) { const f32x4 a = *(const GAS f32x4*)(rsp + rho0 + bj * HALF), b2 = *(const GAS f32x4*)(rsp + rho0 + bj * HALF + 4);
#pragma unroll
                for (int j = 0; j < 4; ++j) { sc[j] = a[j]; sc[4 + j] = b2[j]; } }
            else {
#pragma unroll
                for (int k = 0; k < 8; ++k) sc[k] = __shfl(rt, lb + bj * 8 + k); }
#pragma unroll
            for (int ai = 0; ai < 2; ++ai)
#pragma unroll
                for (int m = 0; m < 4; ++m) { const int f = u.pm * BM + ai * HALF + wr * 64 + m * 16 + fr; GAS bf16_t* rowp = vt + ((size_t)(b * 1024 + f)) * 4096 + w;
                    f32x4 v0 = acc[ai][bj][m][0], v1 = acc[ai][bj][m][1];
#pragma unroll
                    for (int j = 0; j < 4; ++j) { v0[j] *= sc[j]; v1[j] *= sc[4 + j]; }
                    *(GAS u32x4*)(rowp + bj * HALF) = pack8(v0, v1); } }
    }
};
struct EpiRes {
    static constexpr bool PERM = true, AFTER_DRAIN = false;
    const GAS float* resf; GAS bf16_t* hb; GAS float* ss;
    __device__ __forceinline__ void operator()(const f32x4 (&acc)[2][2][4][2], const Unit& u, int wr, int wc, int fr, int fq) const {
        const int col0 = u.pn * BM + wc * 32 + 8 * fq;
#pragma unroll
        for (int ai = 0; ai < 2; ++ai) {
            f32x4 r0[4][2], r1[4][2];
            if (resf) {
#pragma unroll
                for (int m = 0; m < 4; ++m)
#pragma unroll
                    for (int bj = 0; bj < 2; ++bj) { const size_t off = (size_t)(u.pm * BM + ai * HALF + wr * 64 + m * 16 + fr) * 1024 + col0 + bj * HALF;
                        r0[m][bj] = *(const GAS f32x4*)(resf + off); r1[m][bj] = *(const GAS f32x4*)(resf + off + 4); }
            } else { u32x4 w[4][2];
#pragma unroll
                for (int m = 0; m < 4; ++m)
#pragma unroll
                    for (int bj = 0; bj < 2; ++bj) w[m][bj] = *(const GAS u32x4*)(hb + (size_t)(u.pm * BM + ai * HALF + wr * 64 + m * 16 + fr) * 1024 + col0 + bj * HALF);
                asm volatile("" :: "v"(w[0][0]), "v"(w[0][1]), "v"(w[1][0]), "v"(w[1][1]), "v"(w[2][0]), "v"(w[2][1]), "v"(w[3][0]), "v"(w[3][1]));
#pragma unroll
                for (int m = 0; m < 4; ++m)
#pragma unroll
                    for (int bj = 0; bj < 2; ++bj) { const u32x4 x = w[m][bj];
                        r0[m][bj] = (f32x4){__uint_as_float(x.x << 16), __uint_as_float(x.x & 0xffff0000u), __uint_as_float(x.y << 16), __uint_as_float(x.y & 0xffff0000u)};
                        r1[m][bj] = (f32x4){__uint_as_float(x.z << 16), __uint_as_float(x.z & 0xffff0000u), __uint_as_float(x.w << 16), __uint_as_float(x.w & 0xffff0000u)}; } }
#pragma unroll
            for (int m = 0; m < 4; ++m) { const int row = u.pm * BM + ai * HALF + wr * 64 + m * 16 + fr; float q = 0.f;
#pragma unroll
                for (int bj = 0; bj < 2; ++bj) { const size_t off = (size_t)row * 1024 + col0 + bj * HALF;
                    const f32x4 v0 = acc[ai][bj][m][0] + r0[m][bj], v1 = acc[ai][bj][m][1] + r1[m][bj];
                    q += (v0[0] * v0[0] + v0[1] * v0[1]) + (v0[2] * v0[2] + v0[3] * v0[3]) + (v1[0] * v1[0] + v1[1] * v1[1]) + (v1[2] * v1[2] + v1[3] * v1[3]);
                    *(GAS u32x4*)(hb + off) = pack8(v0, v1); }
                q = fq_sum(q);
                if (fq == 0) ss[(size_t)row * 16 + u.pn * 4 + wc] = q; }
        }
    }
};
struct EpiSwiglu {
    static constexpr bool PERM = true, AFTER_DRAIN = false;
    GAS bf16_t* act; const GAS float* ss;
    __device__ __forceinline__ void operator()(const f32x4 (&acc)[2][2][4][2], const Unit& u, int wr, int wc, int fr, int fq) const {
        const int col0 = u.pn * HALF + wc * 32 + 8 * fq; float rr[2][4];
        rows_rs8(ss, u.pm * BM + wr * 64 + fr, fq, rr);
#pragma unroll
        for (int ai = 0; ai < 2; ++ai)
#pragma unroll
            for (int m = 0; m < 4; ++m) { const int row = u.pm * BM + ai * HALF + wr * 64 + m * 16 + fr; const float r = rr[ai][m];
                f32x4 o[2];
#pragma unroll
                for (int n = 0; n < 2; ++n) { const f32x4 gg = acc[ai][0][m][n] * r, uu = acc[ai][1][m][n] * r;
#pragma unroll
                    for (int j = 0; j < 4; ++j) { const float e = __builtin_amdgcn_exp2f(gg[j] * -1.4426950408889634f); o[n][j] = gg[j] * uu[j] * __builtin_amdgcn_rcpf(1.0f + e); } }
                *(GAS u32x4*)(act + (size_t)row * 2816 + col0) = pack8(o[0], o[1]); }
    }
};
struct EpiQKB {
    static constexpr bool PERM = true, AFTER_DRAIN = false;
    GAS bf16_t* out; const GAS float* ss; const GAS float* bf; GAS float* lf;
    __device__ __forceinline__ void operator()(const f32x4 (&acc)[2][2][4][2], const Unit& u, int wr, int wc, int fr, int fq) const {
        const int col0 = u.pn * BM + wc * 32 + 8 * fq; const float qs = (u.pn < 4) ? 0.125f * 1.4426950408889634f : 1.0f; float rr[2][4];
        rows_rs8(ss, u.pm * BM + wr * 64 + fr, fq, rr);
#pragma unroll
        for (int ai = 0; ai < 2; ++ai)
#pragma unroll
            for (int m = 0; m < 4; ++m) { const int row = u.pm * BM + ai * HALF + wr * 64 + m * 16 + fr; const float r0 = rr[ai][m], r = r0 * qs;
                if (u.pn < 8) {
#pragma unroll
                    for (int bj = 0; bj < 2; ++bj) *(GAS u32x4*)(out + (size_t)row * 2048 + col0 + bj * HALF) = pack8(acc[ai][bj][m][0] * r, acc[ai][bj][m][1] * r);
                } else if (wc == 0 && fq < 2) {
                    f32x4 o[2];
#pragma unroll
                    for (int n = 0; n < 2; ++n)
#pragma unroll
                        for (int j = 0; j < 4; ++j) { const float x = acc[ai][0][m][n][j] * r0 + bf[8 * fq + 4 * n + j];
                            const float e = __builtin_amdgcn_exp2f(-fabsf(x) * 1.4426950408889634f); o[n][j] = fminf(x, 0.f) * 1.4426950408889634f - __builtin_amdgcn_logf(1.0f + e); }
                    *(GAS f32x4*)(lf + (size_t)row * 16 + 8 * fq) = o[0]; *(GAS f32x4*)(lf + (size_t)row * 16 + 8 * fq + 4) = o[1];
                } }
    }
};

template <class Epi, class Sched, bool ALIGN_EPI = false, bool SP2 = false>
__device__ __forceinline__ void gemm_phase(PG8_LAS unsigned char* lds, const Gemm g, const Sched& S, const Epi& E, const int tid) {
    const int wid = __builtin_amdgcn_readfirstlane(tid >> 6), lane = tid & 63, wr = wid >> 2, wc = wid & 3, fr = lane & 15, fq = lane >> 4;
    const int K = g.K, nt = K / BK;
    unsigned voffA[2], voffB[2];
#pragma unroll
    for (int i = 0; i < 2; ++i) { int R, C; stage_rc(tid * 16 + i * 8192, R, C); const int Rb = Epi::PERM ? ((R & ~31) + perm32(R & 31)) : R;
        voffA[i] = (unsigned)(R * g.adil * K + C) * 2u; voffB[i] = (unsigned)(Rb * g.bdil * K + C) * 2u; }
    const size_t kstep = (size_t)(BK * 2);
    const size_t hstepA = (size_t)HALF * g.adil * K * 2, hstepB = (size_t)HALF * g.bdil * K * 2;
    const unsigned ldsw = (unsigned)wid * 1024u;
    const int aoff = lds_byte(wr * 64 + fr, fq * 8), boff = lds_byte(wc * 32 + fr, fq * 8);
#define PG8_SA(b, h) (((b) * 2 + (h)) * HTB)
#define PG8_SB(b, h) ((4 + (b) * 2 + (h)) * HTB)
#define PG8_STAGE(bufoff, gbase, voff) do { _Pragma("unroll") for (int _i = 0; _i < 2; ++_i) \
        __builtin_amdgcn_global_load_lds((const GAS unsigned*)((const GAS char*)(gbase) + (voff)[_i]), (PG8_LAS unsigned*)(lds + (bufoff) + ldsw + _i * 8192), 16, 0, 0); } while (0)
#define PG8_LDA(dst, b, h) do { _Pragma("unroll") for (int m = 0; m < 4; ++m) _Pragma("unroll") for (int k = 0; k < 2; ++k) dst[m][k] = *(const PG8_LAS bf16x8*)(lds + PG8_SA(b, h) + aoff + m * 2048 + k * 1024); } while (0)
#define PG8_LDB(dst, b, h) do { _Pragma("unroll") for (int n = 0; n < 2; ++n) _Pragma("unroll") for (int k = 0; k < 2; ++k) dst[n][k] = *(const PG8_LAS bf16x8*)(lds + PG8_SB(b, h) + boff + n * 2048 + k * 1024); } while (0)
#define PG8_MMA(ai, bj, At, Bt) do { __builtin_amdgcn_s_setprio(1); _Pragma("unroll") for (int m = 0; m < 4; ++m) _Pragma("unroll") for (int n = 0; n < 2; ++n) _Pragma("unroll") for (int k = 0; k < 2; ++k) \
        acc[ai][bj][m][n] = __builtin_amdgcn_mfma_f32_16x16x32_bf16(Bt[n][k], At[m][k], acc[ai][bj][m][n], 0, 0, 0); __builtin_amdgcn_s_setprio(0); } while (0)
#define PG8_WAIT_V(n) asm volatile("s_waitcnt vmcnt(" #n ")" ::: "memory")
#define PG8_WAIT_L(n) asm volatile("s_waitcnt lgkmcnt(" #n ")" ::: "memory")
#define PG8_BAR __builtin_amdgcn_s_barrier()
#define PG8_SCHED __builtin_amdgcn_sched_barrier(0)
    Unit cur, nxt; int ui = 0;
    if (!S.next(0, cur)) return;
    f32x4 acc[2][2][4][2];
#pragma unroll
    for (int a = 0; a < 2; ++a)
#pragma unroll
        for (int b = 0; b < 2; ++b)
#pragma unroll
            for (int m = 0; m < 4; ++m)
#pragma unroll
                for (int n = 0; n < 2; ++n) acc[a][b][m][n] = (f32x4){0.f, 0.f, 0.f, 0.f};
    bf16x8 At[4][2], B0[2][2], B1[2][2];
    const GAS char* cA = (const GAS char*)g.A + (size_t)perm_tile_row(cur.pm, g.adil) * K * 2; const GAS char* cB = (const GAS char*)g.Bt + (size_t)perm_tile_row(cur.pn, g.bdil) * K * 2;
    S.a_ready(cur);
    if constexpr (SP2) {
        PG8_STAGE(PG8_SB(0, 0), cB, voffB); PG8_STAGE(PG8_SB(0, 1), cB + hstepB, voffB); PG8_STAGE(PG8_SA(0, 0), cA, voffA); PG8_STAGE(PG8_SA(0, 1), cA + hstepA, voffA);
        if (wr == 1) PG8_BAR;
        PG8_WAIT_V(2); PG8_BAR;
        PG8_STAGE(PG8_SB(1, 0), cB + kstep, voffB); PG8_STAGE(PG8_SA(1, 0), cA + kstep, voffA); PG8_STAGE(PG8_SB(1, 1), cB + hstepB + kstep, voffB);
        PG8_WAIT_V(6); PG8_BAR;
    } else {
        PG8_STAGE(PG8_SB(0, 0), cB, voffB); PG8_STAGE(PG8_SA(0, 0), cA, voffA); PG8_STAGE(PG8_SB(0, 1), cB + hstepB, voffB); PG8_STAGE(PG8_SA(0, 1), cA + hstepA, voffA);
        if (wr == 1) PG8_BAR;
        PG8_WAIT_V(4); PG8_BAR;
        PG8_STAGE(PG8_SB(1, 0), cB + kstep, voffB); PG8_STAGE(PG8_SA(1, 0), cA + kstep, voffA); PG8_STAGE(PG8_SB(1, 1), cB + hstepB + kstep, voffB);
        PG8_WAIT_V(6); PG8_BAR;
    }
    for (;;) {
        const bool has_next = S.next(ui + 1, nxt);
        const GAS char* nA = has_next ? (const GAS char*)g.A + (size_t)perm_tile_row(nxt.pm, g.adil) * K * 2 : cA; const GAS char* nB = has_next ? (const GAS char*)g.Bt + (size_t)perm_tile_row(nxt.pn, g.bdil) * K * 2 : cB;
        for (int t = 0; t < nt; t += 2) {
            const bool last = (t == nt - 2);
            const GAS char* a1 = cA + (size_t)(t + 1) * kstep;
            const GAS char* a2 = last ? nA : cA + (size_t)(t + 2) * kstep; const GAS char* b2 = last ? nB : cB + (size_t)(t + 2) * kstep;
            const GAS char* a3 = a2 + kstep; const GAS char* b3 = b2 + kstep;
            if (last && has_next) S.a_ready(nxt);
            if constexpr (SP2) {
            PG8_LDB(B0, 0, 0); PG8_LDB(B1, 0, 1); PG8_SCHED; PG8_LDA(At, 0, 0); PG8_STAGE(PG8_SA(1, 1), a1 + hstepA, voffA);
            PG8_WAIT_V(8); PG8_WAIT_L(0); PG8_BAR; PG8_MMA(0, 0, At, B0); PG8_MMA(0, 1, At, B1); PG8_BAR; PG8_SCHED;
            PG8_LDA(At, 0, 1); PG8_STAGE(PG8_SB(0, 0), b2, voffB); PG8_STAGE(PG8_SB(0, 1), b2 + hstepB, voffB); PG8_STAGE(PG8_SA(0, 0), a2, voffA);
            PG8_WAIT_V(8); PG8_WAIT_L(0); PG8_BAR; PG8_MMA(1, 0, At, B0); PG8_MMA(1, 1, At, B1); PG8_BAR; PG8_SCHED;
            PG8_LDB(B0, 1, 0); PG8_LDB(B1, 1, 1); PG8_SCHED; PG8_LDA(At, 1, 0); PG8_STAGE(PG8_SA(0, 1), a2 + hstepA, voffA);
            PG8_WAIT_V(8); PG8_WAIT_L(0); PG8_BAR; PG8_MMA(0, 0, At, B0); PG8_MMA(0, 1, At, B1); PG8_BAR; PG8_SCHED;
            PG8_LDA(At, 1, 1); PG8_STAGE(PG8_SB(1, 0), b3, voffB); PG8_STAGE(PG8_SB(1, 1), b3 + hstepB, voffB); PG8_STAGE(PG8_SA(1, 0), a3, voffA);
            PG8_WAIT_V(8); PG8_WAIT_L(0); PG8_BAR; PG8_MMA(1, 0, At, B0); PG8_MMA(1, 1, At, B1); PG8_BAR; PG8_SCHED;
            } else {
            PG8_LDB(B0, 0, 0); PG8_SCHED; PG8_LDA(At, 0, 0); PG8_STAGE(PG8_SA(1, 1), a1 + hstepA, voffA);
            PG8_WAIT_L(8); PG8_BAR; PG8_WAIT_L(0); PG8_MMA(0, 0, At, B0); PG8_BAR; PG8_SCHED;
            PG8_LDB(B1, 0, 1); PG8_STAGE(PG8_SB(0, 0), b2, voffB);
            PG8_BAR; PG8_WAIT_L(0); PG8_MMA(0, 1, At, B1); PG8_BAR;
            PG8_LDA(At, 0, 1); PG8_STAGE(PG8_SA(0, 0), a2, voffA);
            PG8_BAR; PG8_WAIT_L(0); PG8_MMA(1, 0, At, B0); PG8_BAR; PG8_SCHED;
            PG8_STAGE(PG8_SB(0, 1), b2 + hstepB, voffB);
            PG8_WAIT_V(6); PG8_BAR; PG8_MMA(1, 1, At, B1); PG8_BAR;
            PG8_LDB(B0, 1, 0); PG8_SCHED; PG8_LDA(At, 1, 0); PG8_STAGE(PG8_SA(0, 1), a2 + hstepA, voffA);
            PG8_WAIT_L(8); PG8_BAR; PG8_WAIT_L(0); PG8_MMA(0, 0, At, B0); PG8_BAR; PG8_SCHED;
            PG8_LDB(B1, 1, 1); PG8_STAGE(PG8_SB(1, 0), b3, voffB);
            PG8_BAR; PG8_WAIT_L(0); PG8_MMA(0, 1, At, B1); PG8_BAR;
            PG8_LDA(At, 1, 1); PG8_STAGE(PG8_SA(1, 0), a3, voffA);
            PG8_BAR; PG8_WAIT_L(0); PG8_MMA(1, 0, At, B0); PG8_BAR; PG8_SCHED;
            PG8_STAGE(PG8_SB(1, 1), b3 + hstepB, voffB);
            PG8_WAIT_V(6); PG8_BAR; PG8_MMA(1, 1, At, B1); PG8_BAR;
            }
        }
        if constexpr (ALIGN_EPI) { if (wr == 0) PG8_BAR; }
        if constexpr (!Epi::AFTER_DRAIN) { E(acc, cur, wr, wc, fr, fq); S.done(cur); }
        if (!has_next) break;
#pragma unroll
        for (int a = 0; a < 2; ++a)
#pragma unroll
            for (int b = 0; b < 2; ++b)
#pragma unroll
                for (int m = 0; m < 4; ++m)
#pragma unroll
                    for (int n = 0; n < 2; ++n) acc[a][b][m][n] = (f32x4){0.f, 0.f, 0.f, 0.f};
        cur = nxt; cA = nA; cB = nB; ++ui;
        if constexpr (ALIGN_EPI) { if (wr == 1) PG8_BAR; }
    }
    PG8_WAIT_V(0);
    if constexpr (!ALIGN_EPI) { if (wr == 0) PG8_BAR; }
    PG8_BAR;
    if constexpr (Epi::AFTER_DRAIN) { E.fused(acc, cur, wr, wc, fr, fq, lds, wid, lane); S.done(cur); }
#undef PG8_SA
#undef PG8_SB
#undef PG8_STAGE
#undef PG8_LDA
#undef PG8_LDB
#undef PG8_MMA
#undef PG8_WAIT_V
#undef PG8_WAIT_L
#undef PG8_BAR
#undef PG8_SCHED
}
}

namespace att {
typedef unsigned short bf16_t;
typedef short bf16x8 __attribute__((ext_vector_type(8)));
typedef float f32x16 __attribute__((ext_vector_type(16)));
typedef float f32x4 __attribute__((ext_vector_type(4)));
typedef unsigned u32x2 __attribute__((ext_vector_type(2)));
typedef unsigned u32x4 __attribute__((ext_vector_type(4)));
typedef float f32x2_t __attribute__((ext_vector_type(2))); typedef __bf16 bf16x2_t __attribute__((ext_vector_type(2)));
__device__ __forceinline__ unsigned cvtpk(float lo, float hi) { f32x2_t v = {lo, hi}; bf16x2_t b = __builtin_convertvector(v, bf16x2_t); return __builtin_bit_cast(unsigned, b); }
__device__ __forceinline__ float bflo(unsigned w) { return __uint_as_float(w << 16); }
__device__ __forceinline__ float bfhi(unsigned w) { return __uint_as_float(w & 0xffff0000u); }
constexpr float NEG = -1e30f;

struct KV { bf16x8 k[4]; bf16x8 v[2][2]; };
__device__ __forceinline__ void load_kv(KV& t, const GAS bf16_t* Kp, const GAS bf16_t* Vp, int key0) {
#pragma unroll
    for (int d0 = 0; d0 < 4; ++d0) t.k[d0] = *(const GAS bf16x8*)(Kp + (size_t)key0 * 2048 + 16 * d0);
#pragma unroll
    for (int dh = 0; dh < 2; ++dh)
#pragma unroll
        for (int kc = 0; kc < 2; ++kc) t.v[dh][kc] = *(const GAS bf16x8*)(Vp + (size_t)dh * 32 * 4096 + key0 + 16 * kc);
}
struct St { float m, l; f32x16 o0, o1; };
__device__ __forceinline__ f32x16 qk(const KV& t, const bf16x8 (&qf)[4], f32x16 s = f32x16{}) {
#pragma unroll
    for (int d0 = 0; d0 < 4; ++d0) s = __builtin_amdgcn_mfma_f32_32x32x16_bf16(t.k[d0], qf[d0], s, 0, 0, 0);
    return s;
}
__device__ __forceinline__ void upd(St& S, f32x16 st, const KV& t) {
    float mx = fmaxf(fmaxf(st[0], st[1]), fmaxf(st[2], st[3]));
#pragma unroll
    for (int r = 4; r < 16; r += 4) mx = fmaxf(mx, fmaxf(fmaxf(st[r], st[r + 1]), fmaxf(st[r + 2], st[r + 3])));
    mx = fmaxf(mx, __shfl_xor(mx, 32));
    const float mnew = fmaxf(S.m, mx), alpha = __builtin_amdgcn_exp2f(S.m - mnew); S.m = mnew;
    float ps = 0.f;
#pragma unroll
    for (int r = 0; r < 16; ++r) { st[r] = __builtin_amdgcn_exp2f(st[r] - mnew); ps += st[r]; }
    S.l = S.l * alpha + ps;
    if (__any(alpha != 1.0f)) { S.o0 *= alpha; S.o1 *= alpha; }
    u32x4 w0, w1;
    w0.x = cvtpk(st[0], st[1]); w0.y = cvtpk(st[2], st[3]); w0.z = cvtpk(st[4], st[5]); w0.w = cvtpk(st[6], st[7]);
    w1.x = cvtpk(st[8], st[9]); w1.y = cvtpk(st[10], st[11]); w1.z = cvtpk(st[12], st[13]); w1.w = cvtpk(st[14], st[15]);
    const bf16x8 p0 = __builtin_bit_cast(bf16x8, w0), p1 = __builtin_bit_cast(bf16x8, w1);
    S.o0 = __builtin_amdgcn_mfma_f32_32x32x16_bf16(t.v[0][0], p0, S.o0, 0, 0, 0); S.o0 = __builtin_amdgcn_mfma_f32_32x32x16_bf16(t.v[0][1], p1, S.o0, 0, 0, 0);
    S.o1 = __builtin_amdgcn_mfma_f32_32x32x16_bf16(t.v[1][0], p0, S.o1, 0, 0, 0); S.o1 = __builtin_amdgcn_mfma_f32_32x32x16_bf16(t.v[1][1], p1, S.o1, 0, 0, 0);
}
__device__ __forceinline__ void upd64(St& S, f32x16 s0, f32x16 s1, const KV& t0, const KV& t1) {
    float mx = fmaxf(fmaxf(s0[0], s0[1]), fmaxf(s1[0], s1[1]));
#pragma unroll
    for (int r = 2; r < 16; r += 2) mx = fmaxf(mx, fmaxf(fmaxf(s0[r], s0[r + 1]), fmaxf(s1[r], s1[r + 1])));
    mx = fmaxf(mx, __shfl_xor(mx, 32));
    const float mnew = fmaxf(S.m, mx), alpha = __builtin_amdgcn_exp2f(S.m - mnew); S.m = mnew;
    s0 = s0 - mnew; s1 = s1 - mnew;
    float pa = 0.f, pb = 0.f;
#pragma unroll
    for (int r = 0; r < 16; ++r) { s0[r] = __builtin_amdgcn_exp2f(s0[r]); s1[r] = __builtin_amdgcn_exp2f(s1[r]); pa += s0[r]; pb += s1[r]; }
    S.l = S.l * alpha + (pa + pb);
    if (__any(alpha != 1.0f)) { S.o0 *= alpha; S.o1 *= alpha; }
    u32x4 w0, w1, w2, w3;
    w0.x = cvtpk(s0[0], s0[1]); w0.y = cvtpk(s0[2], s0[3]); w0.z = cvtpk(s0[4], s0[5]); w0.w = cvtpk(s0[6], s0[7]);
    w1.x = cvtpk(s0[8], s0[9]); w1.y = cvtpk(s0[10], s0[11]); w1.z = cvtpk(s0[12], s0[13]); w1.w = cvtpk(s0[14], s0[15]);
    w2.x = cvtpk(s1[0], s1[1]); w2.y = cvtpk(s1[2], s1[3]); w2.z = cvtpk(s1[4], s1[5]); w2.w = cvtpk(s1[6], s1[7]);
    w3.x = cvtpk(s1[8], s1[9]); w3.y = cvtpk(s1[10], s1[11]); w3.z = cvtpk(s1[12], s1[13]); w3.w = cvtpk(s1[14], s1[15]);
    const bf16x8 p0 = __builtin_bit_cast(bf16x8, w0), p1 = __builtin_bit_cast(bf16x8, w1), p2 = __builtin_bit_cast(bf16x8, w2), p3 = __builtin_bit_cast(bf16x8, w3);
    S.o0 = __builtin_amdgcn_mfma_f32_32x32x16_bf16(t0.v[0][0], p0, S.o0, 0, 0, 0); S.o1 = __builtin_amdgcn_mfma_f32_32x32x16_bf16(t0.v[1][0], p0, S.o1, 0, 0, 0);
    S.o0 = __builtin_amdgcn_mfma_f32_32x32x16_bf16(t0.v[0][1], p1, S.o0, 0, 0, 0); S.o1 = __builtin_amdgcn_mfma_f32_32x32x16_bf16(t0.v[1][1], p1, S.o1, 0, 0, 0);
    S.o0 = __builtin_amdgcn_mfma_f32_32x32x16_bf16(t1.v[0][0], p2, S.o0, 0, 0, 0); S.o1 = __builtin_amdgcn_mfma_f32_32x32x16_bf16(t1.v[1][0], p2, S.o1, 0, 0, 0);
    S.o0 = __builtin_amdgcn_mfma_f32_32x32x16_bf16(t1.v[0][1], p3, S.o0, 0, 0, 0); S.o1 = __builtin_amdgcn_mfma_f32_32x32x16_bf16(t1.v[1][1], p3, S.o1, 0, 0, 0);
}
#define ATT_KEYREL(r, hi) (16 * ((r) >> 3) + 8 * (hi) + ((r) & 7))

__device__ __forceinline__ void glds16(const GAS void* gsrc, unsigned lds_dst) { unsigned keep;
    asm volatile("s_mov_b32 %0, m0\n\ts_mov_b32 m0, %2\n\ts_nop 0\n\tglobal_load_lds_dwordx4 %1, off\n\ts_mov_b32 m0, %0" : "=&s"(keep) : "v"(gsrc), "s"(lds_dst) : "memory"); }
__device__ __forceinline__ void pv8(St& S, const bf16x8 (&pp)[4], const bf16x8 (&vv)[8]) {
#pragma unroll
    for (int i = 0; i < 4; ++i) { const int sub = i >> 1, kc = i & 1;
        S.o0 = __builtin_amdgcn_mfma_f32_32x32x16_bf16(vv[4 * sub + kc], pp[i], S.o0, 0, 0, 0);
        S.o1 = __builtin_amdgcn_mfma_f32_32x32x16_bf16(vv[4 * sub + 2 + kc], pp[i], S.o1, 0, 0, 0); }
}
__device__ __forceinline__ void fox_unit3(int b, int h, int qb, const GAS bf16_t* __restrict__ QK, const GAS bf16_t* __restrict__ VT, GAS bf16_t* O, const LAS float* ncs, LAS unsigned char* ring, int wid, int lane) {
    const int r32 = lane & 31, hi = lane >> 5, q0 = 256 * qb + 32 * wid;
    const int kap = (r32 & 0x13) | ((r32 & 4) << 1) | ((r32 & 8) >> 1);
    const GAS bf16_t* Qp = QK + (size_t)(b * 4096 + q0 + r32) * 2048 + h * 64 + 8 * hi;
    bf16x8 qf[4];
#pragma unroll
    for (int d0 = 0; d0 < 4; ++d0) qf[d0] = *(const GAS bf16x8*)(Qp + 16 * d0);
    const GAS bf16_t* src; size_t kstep;
    if (wid < 4) { src = QK + (size_t)(b * 4096 + kap) * 2048 + 1024 + h * 64 + 8 * hi + 16 * wid; kstep = 2048; }
    else { const int f = wid - 4; src = VT + (size_t)(b * 1024 + h * 64 + 32 * (f >> 1) + r32) * 4096 + 8 * hi + 16 * (f & 1); kstep = 1; }
    const unsigned ldst = (unsigned)__builtin_amdgcn_readfirstlane((int)((unsigned)(uintptr_t)ring + (unsigned)wid * 1024u));
#define FX_DMA(T) do { const GAS bf16_t* s_ = src + (size_t)(64 * (T)) * kstep; const unsigned d_ = ldst + (unsigned)((T) & 3) * 16384u; glds16(s_, d_); glds16(s_ + 32 * kstep, d_ + 8192u); } while (0)
    const int nT = 4 * qb + 4, Tl = (8 * qb + wid) >> 1, qrow = 32 * wid + r32;
    St S; S.m = NEG; S.l = 0.f; S.o0 = f32x16{}; S.o1 = f32x16{};
    bf16x8 kf[8], vprev[8], pprev[4];
#pragma unroll
    for (int i = 0; i < 8; ++i) vprev[i] = bf16x8{};
#pragma unroll
    for (int i = 0; i < 4; ++i) pprev[i] = bf16x8{};
    FX_DMA(nT - 1); FX_DMA(nT - 2); FX_DMA(nT - 3);
    asm volatile("" :: "v"(qf[0]), "v"(qf[1]), "v"(qf[2]), "v"(qf[3]));
#define FX_RDK(T) do { const LAS unsigned char* fb = ring + ((T) & 3) * 16384 + lane * 16; \
        _Pragma("unroll") for (int i = 0; i < 8; ++i) kf[i] = *(const LAS bf16x8*)(fb + (i >> 2) * 8192 + (i & 3) * 1024); } while (0)
#define FX_RDC(T) do { const LAS f32x4* cp = (const LAS f32x4*)(ncs + 64 * (T) + 8 * hi); \
        const f32x4 a0 = cp[0], a1 = cp[1], a2 = cp[4], a3 = cp[5], b0 = cp[8], b1 = cp[9], b2 = cp[12], b3 = cp[13]; \
        _Pragma("unroll") for (int j = 0; j < 4; ++j) { c0[j] = a0[j]; c0[4 + j] = a1[j]; c0[8 + j] = a2[j]; c0[12 + j] = a3[j]; c1[j] = b0[j]; c1[4 + j] = b1[j]; c1[8 + j] = b2[j]; c1[12 + j] = b3[j]; } } while (0)
    f32x16 c0 = f32x16{}, c1 = f32x16{};
#define FX_RDV(T) do { const LAS unsigned char* fb = ring + ((T) & 3) * 16384 + 4096 + lane * 16; \
        _Pragma("unroll") for (int i = 0; i < 8; ++i) vprev[i] = *(const LAS bf16x8*)(fb + (i >> 2) * 8192 + (i & 3) * 1024); } while (0)
    for (int T = nT - 1; T >= 0; --T) {
        if (T >= 2) asm volatile("s_waitcnt vmcnt(2) lgkmcnt(0)" ::: "memory"); else asm volatile("s_waitcnt vmcnt(0) lgkmcnt(0)" ::: "memory");
        __builtin_amdgcn_s_barrier(); asm volatile("" ::: "memory");
        if (T >= 3) FX_DMA(T - 3);
        if (T <= Tl) {
            if (T == Tl) FX_RDK(T);
            FX_RDC(T);
            f32x16 s0 = c0, s1 = c1;
#pragma unroll
            for (int d0 = 0; d0 < 4; ++d0) { s0 = __builtin_amdgcn_mfma_f32_32x32x16_bf16(kf[d0], qf[d0], s0, 0, 0, 0); s1 = __builtin_amdgcn_mfma_f32_32x32x16_bf16(kf[4 + d0], qf[d0], s1, 0, 0, 0); }
            FX_RDK(T - 1);
            if (T == Tl) { const int kb = 64 * T - 256 * qb;
#pragma unroll
                for (int r = 0; r < 16; ++r) { if (kb + ATT_KEYREL(r, hi) > qrow) s0[r] = NEG; if (kb + 32 + ATT_KEYREL(r, hi) > qrow) s1[r] = NEG; } }
            pv8(S, pprev, vprev);
            FX_RDV(T);
            float ma = __builtin_fmaxf(__builtin_fmaxf(s0[0], s0[1]), s0[2]), mb = __builtin_fmaxf(__builtin_fmaxf(s1[0], s1[1]), s1[2]);
            ma = __builtin_fmaxf(ma, s0[3]); mb = __builtin_fmaxf(mb, s1[3]);
#pragma unroll
            for (int r = 4; r < 16; r += 2) { ma = __builtin_fmaxf(__builtin_fmaxf(ma, s0[r]), s0[r + 1]); mb = __builtin_fmaxf(__builtin_fmaxf(mb, s1[r]), s1[r + 1]); }
            float mx = __builtin_fmaxf(ma, mb); mx = __builtin_fmaxf(mx, __shfl_xor(mx, 32));
            const float mnew = __builtin_fmaxf(S.m, mx), alpha = __builtin_amdgcn_exp2f(S.m - mnew); S.m = mnew;
            s0 = s0 - mnew; s1 = s1 - mnew;
#pragma unroll
            for (int r = 0; r < 16; ++r) { s0[r] = __builtin_amdgcn_exp2f(s0[r]); s1[r] = __builtin_amdgcn_exp2f(s1[r]); }
            { const f32x16 t = s0 + s1; float pa = (t[0] + t[1]) + (t[2] + t[3]), pb = (t[4] + t[5]) + (t[6] + t[7]), pc = (t[8] + t[9]) + (t[10] + t[11]), pd = (t[12] + t[13]) + (t[14] + t[15]);
              S.l = S.l * alpha + ((pa + pb) + (pc + pd)); }
            if (__any(alpha != 1.0f)) { S.o0 *= alpha; S.o1 *= alpha; }
            u32x4 w0, w1, w2, w3;
            w0.x = cvtpk(s0[0], s0[1]); w0.y = cvtpk(s0[2], s0[3]); w0.z = cvtpk(s0[4], s0[5]); w0.w = cvtpk(s0[6], s0[7]);
            w1.x = cvtpk(s0[8], s0[9]); w1.y = cvtpk(s0[10], s0[11]); w1.z = cvtpk(s0[12], s0[13]); w1.w = cvtpk(s0[14], s0[15]);
            w2.x = cvtpk(s1[0], s1[1]); w2.y = cvtpk(s1[2], s1[3]); w2.z = cvtpk(s1[4], s1[5]); w2.w = cvtpk(s1[6], s1[7]);
            w3.x = cvtpk(s1[8], s1[9]); w3.y = cvtpk(s1[10], s1[11]); w3.z = cvtpk(s1[12], s1[13]); w3.w = cvtpk(s1[14], s1[15]);
            pprev[0] = __builtin_bit_cast(bf16x8, w0); pprev[1] = __builtin_bit_cast(bf16x8, w1); pprev[2] = __builtin_bit_cast(bf16x8, w2); pprev[3] = __builtin_bit_cast(bf16x8, w3);
        }
    }
    pv8(S, pprev, vprev);
#undef FX_DMA
#undef FX_RDK
#undef FX_RDV
#undef FX_RDC
    const float lt = S.l + __shfl_xor(S.l, 32); const float inv = __builtin_amdgcn_rcpf(lt);
    GAS bf16_t* Op = O + (size_t)(b * 4096 + q0 + r32) * 1024 + h * 64 + 4 * hi;
#pragma unroll
    for (int dh = 0; dh < 2; ++dh)
#pragma unroll
        for (int rg = 0; rg < 4; ++rg) { const f32x16& o = dh ? S.o1 : S.o0; u32x2 w; w.x = cvtpk(o[4 * rg] * inv, o[4 * rg + 1] * inv); w.y = cvtpk(o[4 * rg + 2] * inv, o[4 * rg + 3] * inv);
            *(GAS u32x2*)(Op + 32 * dh + 8 * rg) = w; }
    asm volatile("s_waitcnt lgkmcnt(0)" ::: "memory"); __builtin_amdgcn_s_barrier(); asm volatile("" ::: "memory");
}

__device__ __forceinline__ void attn0_phase(int g, int vcu, const GAS bf16_t* __restrict__ QK, const GAS bf16_t* __restrict__ VT, GAS bf16_t* O, GAS float* LSE, LAS unsigned char* ring, int wid, int lane) {
    const int r32 = lane & 31, hi = lane >> 5, lgd = 2 * g, lgL = 12 - lgd, TLm = (128 >> lgd) - 1;
    const int kap = (r32 & 0x13) | ((r32 & 4) << 1) | ((r32 & 8) >> 1);
    const unsigned ldst = (unsigned)__builtin_amdgcn_readfirstlane((int)((unsigned)(uintptr_t)ring + (unsigned)wid * 1024u));
    for (int su = vcu; su < 256; su += (int)gridDim.x) {
        const int bh = su >> 1, b = bh >> 4, h = bh & 15, half = su & 1;
        const GAS bf16_t* src; size_t tstep;
        if (wid < 4) { src = QK + (size_t)(b * 4096 + kap) * 2048 + 1024 + h * 64 + 8 * hi + 16 * wid; tstep = (size_t)32 * 2048; }
        else { const int f = wid - 4; src = VT + (size_t)(b * 1024 + h * 64 + 32 * (f >> 1) + r32) * 4096 + 8 * hi + 16 * (f & 1); tstep = 32; }
        for (int j = 0; j < 8; ++j) {
            const int rt0 = 64 * half + 8 * j, lt0 = rt0 & TLm;
            const int lo = (j == 0) ? ((lt0 == 0) ? rt0 : rt0 - 4) : rt0;
            asm volatile("s_waitcnt lgkmcnt(0)" ::: "memory"); __builtin_amdgcn_s_barrier(); asm volatile("" ::: "memory");
            for (int gt = lo; gt < rt0 + 8; ++gt) glds16(src + (size_t)gt * tstep, ldst + (unsigned)(gt & 15) * 8192u);
            const int rt = rt0 + wid, lt = lt0 + wid, kt0 = (lt >= 4) ? 0 : 4 - lt;
            const int w0 = rt * 32, c = w0 >> lgL, i0 = w0 & ((1 << lgL) - 1);
            const GAS bf16_t* Qp = QK + (size_t)(b * 4096 + w0 + r32) * 2048 + h * 64 + 8 * hi;
            bf16x8 qf[4];
#pragma unroll
            for (int d0 = 0; d0 < 4; ++d0) qf[d0] = *(const GAS bf16x8*)(Qp + 16 * d0);
            const int row = b * 4096 + ((i0 + r32) << lgd) + c;
            GAS bf16_t* Op = O + (size_t)row * 1024 + h * 64 + 4 * hi;
            u32x2 pv[8]; float lp = 0.f;
            if (g > 0) { lp = LSE[(size_t)row * 16 + h];
#pragma unroll
                for (int i = 0; i < 8; ++i) pv[i] = *(const GAS u32x2*)(Op + 32 * (i >> 2) + 8 * (i & 3)); }
            asm volatile("s_waitcnt vmcnt(0)" ::: "memory"); __builtin_amdgcn_s_barrier(); asm volatile("" ::: "memory");
            St S; S.m = NEG; S.l = 0.f; S.o0 = f32x16{}; S.o1 = f32x16{};
#define A0_LDT(KVv, gt_) do { const LAS unsigned char* fb = ring + ((gt_) & 15) * 8192 + lane * 16; \
                _Pragma("unroll") for (int d0 = 0; d0 < 4; ++d0) KVv.k[d0] = *(const LAS bf16x8*)(fb + d0 * 1024); \
                _Pragma("unroll") for (int f = 0; f < 4; ++f) KVv.v[f >> 1][f & 1] = *(const LAS bf16x8*)(fb + 4096 + f * 1024); } while (0)
            if (kt0 == 0) {
                KV ka, kb;
                A0_LDT(ka, rt - 4); A0_LDT(kb, rt - 3);
                { f32x16 st = qk(ka, qf);
#pragma unroll
                  for (int r = 0; r < 16; ++r) if (ATT_KEYREL(r, hi) < r32) st[r] = NEG;
                  upd(S, st, ka); }
                A0_LDT(ka, rt - 2);
                upd64(S, qk(kb, qf), qk(ka, qf), kb, ka);
                A0_LDT(kb, rt - 1); A0_LDT(ka, rt);
                { f32x16 s1 = qk(ka, qf);
#pragma unroll
                  for (int r = 0; r < 16; ++r) if (ATT_KEYREL(r, hi) > r32) s1[r] = NEG;
                  upd64(S, qk(kb, qf), s1, kb, ka); }
            } else {
                for (int kt = kt0; kt < 5; ++kt) { KV ka; A0_LDT(ka, rt - 4 + kt); f32x16 st = qk(ka, qf);
                    if (kt == 4) {
#pragma unroll
                        for (int r = 0; r < 16; ++r) if (ATT_KEYREL(r, hi) > r32) st[r] = NEG; }
                    upd(S, st, ka); }
            }
#undef A0_LDT
            const float lt_ = S.l + __shfl_xor(S.l, 32); float inv = __builtin_amdgcn_rcpf(lt_); float lse = S.m + __builtin_amdgcn_logf(lt_);
            float wprev = 0.f;
            if (g > 0) { const float mn = fmaxf(lp, lse), ea = __builtin_amdgcn_exp2f(lse - mn), eb = __builtin_amdgcn_exp2f(lp - mn), den = ea + eb, rd = __builtin_amdgcn_rcpf(den);
                inv *= ea * rd; wprev = eb * rd; lse = mn + __builtin_amdgcn_logf(den); }
#pragma unroll
            for (int dh = 0; dh < 2; ++dh)
#pragma unroll
                for (int rg = 0; rg < 4; ++rg) { const f32x16& o = dh ? S.o1 : S.o0; float v0 = o[4 * rg] * inv, v1 = o[4 * rg + 1] * inv, v2 = o[4 * rg + 2] * inv, v3 = o[4 * rg + 3] * inv;
                    if (g > 0) { const u32x2 p = pv[4 * dh + rg]; v0 += wprev * bflo(p.x); v1 += wprev * bfhi(p.x); v2 += wprev * bflo(p.y); v3 += wprev * bfhi(p.y); }
                    u32x2 w; w.x = cvtpk(v0, v1); w.y = cvtpk(v2, v3); *(GAS u32x2*)(Op + 32 * dh + 8 * rg) = w; }
            if (hi == 0) LSE[(size_t)row * 16 + h] = lse;
        }
    }
    asm volatile("s_waitcnt lgkmcnt(0)" ::: "memory"); __builtin_amdgcn_s_barrier(); asm volatile("" ::: "memory");
}
}

typedef unsigned short bf16;
typedef float f32x4 __attribute__((ext_vector_type(4)));
typedef unsigned v4u __attribute__((ext_vector_type(4)));
constexpr size_t MiB = 1u << 20;
constexpr size_t WS_ROT = 0, WS_RSP = 256 * 1024, WS_BAR = 768 * 1024, WS_SS = 1 * MiB, WS_LF = 9 * MiB, WS_LSE = 11 * MiB;
constexpr size_t WS_WTA = 16 * MiB, WS_WTAO = 34 * MiB, WS_WTB = 36 * MiB, WS_WTBV = 41 * MiB, WS_WTBO = 43 * MiB, WS_WTGU = 45 * MiB, WS_WTD = 67 * MiB;
constexpr size_t WS_XB = 80 * MiB, WS_O = 144 * MiB, WS_QK = 208 * MiB, WS_VT = 336 * MiB, WS_ACT = 208 * MiB, WS_END = 464 * MiB;
constexpr size_t SZ_WTGU = 11 * MiB, SZ_WTD = (size_t)1024 * 2816 * 2, SZ_SS = 2 * MiB;
constexpr int NWAVES = 8, LDS_BYTES = 147456;
constexpr int NPH = 16;

#define XB_TMO      128
#define XB_XCNT(j)  (256  + 64 * (j))
#define XB_CEN      3400
#define XB_XSUB(j)  (1280 + 64 * (j))
#define XB_XGEN(j)  (2304 + 64 * (j))
#define XB_TOP      3328
#define XB_TOPGEN   3392
#define XCD_BAR_WORDS 3456
#define XB_SPIN_CAP (1u << 18)

__device__ __forceinline__ unsigned xb_ld(unsigned* p)              { return __hip_atomic_load(p, __ATOMIC_RELAXED, __HIP_MEMORY_SCOPE_AGENT); }
__device__ __forceinline__ unsigned xb_add(unsigned* p, unsigned v) { return __hip_atomic_fetch_add(p, v, __ATOMIC_RELAXED, __HIP_MEMORY_SCOPE_AGENT); }
__device__ __forceinline__ unsigned xb_xcc_id() { return (unsigned)__builtin_amdgcn_s_getreg((3 << 11) | 20) & 0xFu; }
#define XB_SPIN(cond, bar) do { unsigned _sp = 0; while (cond) { __builtin_amdgcn_s_sleep(1); \
    if ((++_sp & 255u) == 0u) { if (xb_ld(&(bar)[XB_TMO])) break; if (_sp > XB_SPIN_CAP) { atomicAdd(&(bar)[XB_TMO], 1u); break; } } } } while (0)

struct XcdBarrier {
    unsigned* bar; unsigned x;
    volatile LAS unsigned* st;
};

__device__ __forceinline__ XcdBarrier xcd_barrier_post(unsigned* bar, volatile LAS unsigned* st) {
    XcdBarrier b; b.bar = bar; b.x = xb_xcc_id(); b.st = st;
    if (threadIdx.x == 0) (void)__hip_atomic_fetch_add((unsigned long long*)&bar[XB_CEN + 2 * (b.x >> 3)], 1ull << (8 * (b.x & 7)), __ATOMIC_RELAXED, __HIP_MEMORY_SCOPE_AGENT);
    return b;
}
__device__ __forceinline__ void xcd_barrier_complete(unsigned* bar, unsigned x, unsigned& nloc, unsigned& nx) {
    const unsigned G = gridDim.x * gridDim.y * gridDim.z;
    unsigned sum, cnt, mine, sp = 0u;
    for (;;) {
        sum = 0u; cnt = 0u; mine = 0u;
        const unsigned long long ca = __hip_atomic_load((unsigned long long*)&bar[XB_CEN], __ATOMIC_RELAXED, __HIP_MEMORY_SCOPE_AGENT), cb = __hip_atomic_load((unsigned long long*)&bar[XB_CEN + 2], __ATOMIC_RELAXED, __HIP_MEMORY_SCOPE_AGENT);
#pragma unroll
        for (unsigned j = 0; j < 16; ++j) { const unsigned c = (unsigned)(((j < 8u) ? (ca >> (8u * j)) : (cb >> (8u * (j - 8u)))) & 255ull); sum += c; cnt += (c > 0u) ? 1u : 0u; mine = (j == x) ? c : mine; }
        if (sum == G) break;
        __builtin_amdgcn_s_sleep(1);
        if ((++sp & 255u) == 0u) { if (xb_ld(&bar[XB_TMO])) break; if (sp > XB_SPIN_CAP) { atomicAdd(&bar[XB_TMO], 1u); break; } }
    }
    nloc = mine > 0u ? mine : 1u; nx = cnt > 0u ? cnt : 1u;
}

__device__ __forceinline__ void xcd_barrier(const XcdBarrier& b) {
    asm volatile("s_waitcnt vmcnt(0)" ::: "memory");
    __syncthreads();
    if (threadIdx.x == 0) {
        unsigned* bar = b.bar;
        __builtin_amdgcn_s_waitcnt(0);
        unsigned nloc = b.st[0], nx = b.st[1];
        if (nloc == 0u) { xcd_barrier_complete(bar, b.x, nloc, nx); b.st[0] = nloc; b.st[1] = nx; }
        const unsigned old = xb_add(&bar[XB_XSUB(b.x)], 1u);
        const unsigned gen = old / nloc;
        if (old + 1u == (gen + 1u) * nloc) {
            __builtin_amdgcn_fence(__ATOMIC_RELEASE, "agent");
            asm volatile("s_waitcnt vmcnt(0)" ::: "memory");
            const unsigned og = xb_add(&bar[XB_TOP], 1u);
            const unsigned tg = og / nx;
            if (og + 1u == (tg + 1u) * nx) xb_add(&bar[XB_TOPGEN], 1u);
            else XB_SPIN(xb_ld(&bar[XB_TOPGEN]) == tg, bar);
            __builtin_amdgcn_fence(__ATOMIC_ACQUIRE, "agent");
            xb_add(&bar[XB_XGEN(b.x)], 1u);
            asm volatile("s_waitcnt vmcnt(0)" ::: "memory");
        } else {
            XB_SPIN(xb_ld(&bar[XB_XGEN(b.x)]) == gen, bar);
            __builtin_amdgcn_fence(__ATOMIC_ACQUIRE, "agent");
            asm volatile("s_waitcnt vmcnt(0)" ::: "memory");
        }
    }
    __syncthreads();
}


struct Args {
    const float* x; const float* a_norm; const float* a_w_in; const float* a_w_out; const float* b_norm; const float* b_w_in; const float* b_f; const float* b_w_out;
    const float* ffn_norm; const float* ffn_w_gu; const float* ffn_w_down; const float* final_norm; float* out; unsigned char* ws; int ph_lo, ph_hi;
};

__device__ __forceinline__ unsigned f2bf(float f) { unsigned u = __builtin_bit_cast(unsigned, f); return (u + 0x7fffu + ((u >> 16) & 1u)) >> 16; }
__device__ __forceinline__ unsigned pk2(float lo, float hi) { return pg8::cvt_pk_bf16(lo, hi); }
__device__ __forceinline__ float wave_sum(float v) {
#pragma unroll
    for (int o = 1; o < 64; o <<= 1) v += __shfl_xor(v, o);
    return v;
}
__device__ __forceinline__ void transpose_item(const GAS float* __restrict__ W, int ldw, int k0, int nsrc0, const GAS float* __restrict__ gain, GAS bf16* WT, int Kd, int drow0, LAS float* scr, int lane) {
    float wv[32];
    const GAS float* wp = W + (size_t)(k0 + (lane >> 5)) * ldw + nsrc0 + (lane & 31);
#pragma unroll
    for (int i = 0; i < 32; ++i) wv[i] = wp[(size_t)(2 * i) * ldw];
    const int c = lane & 7;
    f32x4 g0 = {1.f, 1.f, 1.f, 1.f}, g1 = {1.f, 1.f, 1.f, 1.f};
    if (gain) { g0 = *(const GAS f32x4*)(gain + k0 + 8 * c); g1 = *(const GAS f32x4*)(gain + k0 + 8 * c + 4); }
    asm volatile("" :: "v"(wv[0]), "v"(wv[1]), "v"(wv[2]), "v"(wv[3]), "v"(wv[4]), "v"(wv[5]), "v"(wv[6]), "v"(wv[7]), "v"(wv[8]), "v"(wv[9]), "v"(wv[10]), "v"(wv[11]), "v"(wv[12]), "v"(wv[13]), "v"(wv[14]), "v"(wv[15]));
    asm volatile("" :: "v"(wv[16]), "v"(wv[17]), "v"(wv[18]), "v"(wv[19]), "v"(wv[20]), "v"(wv[21]), "v"(wv[22]), "v"(wv[23]), "v"(wv[24]), "v"(wv[25]), "v"(wv[26]), "v"(wv[27]), "v"(wv[28]), "v"(wv[29]), "v"(wv[30]), "v"(wv[31]));
#pragma unroll
    for (int i = 0; i < 32; ++i) scr[(2 * i + (lane >> 5)) * 33 + (lane & 31)] = wv[i];
    asm volatile("s_waitcnt lgkmcnt(0)" ::: "memory");
#pragma unroll
    for (int j = 0; j < 4; ++j) { const int n = (lane >> 3) + 8 * j; const LAS float* s = scr + (8 * c) * 33 + n;
        v4u o; o.x = pk2(s[0 * 33] * g0[0], s[1 * 33] * g0[1]); o.y = pk2(s[2 * 33] * g0[2], s[3 * 33] * g0[3]); o.z = pk2(s[4 * 33] * g1[0], s[5 * 33] * g1[1]); o.w = pk2(s[6 * 33] * g1[2], s[7 * 33] * g1[3]);
        *(GAS v4u*)(WT + (size_t)(drow0 + n) * Kd + k0 + 8 * c) = o; }
    asm volatile("s_waitcnt lgkmcnt(0)" ::: "memory");
}

__device__ __forceinline__ void prologue(const Args& a, GAS unsigned char* ws, int bid, LAS unsigned char* lds, int tid, int lane, int wave) {
    LAS float* scr = (LAS float*)(lds + wave * 16384);
    const int gw = bid * NWAVES + wave, NGW = gridDim.x * NWAVES;
    const int gt = bid * (NWAVES * 64) + tid, NGT = gridDim.x * NWAVES * 64;
    constexpr int I_A = 16 * 288, I_AO = 16 * 32, I_BQK = 16 * 64, I_BV = 16 * 32, I_BO = 16 * 32, I_GU = 16 * 176, I_D = 44 * 32;
    constexpr int NITEMS = I_A + I_AO + I_BQK + I_BV + I_BO + 2 * I_GU + 2 * I_D;
    for (int it = gw; it < NITEMS; it += NGW) {
        int r = it;
        if (r < I_A) { const int kb = r / 288, nb = r % 288; transpose_item((const GAS float*)a.a_w_in, 9216, 64 * kb, 32 * nb, (const GAS float*)a.a_norm, (GAS bf16*)(ws + WS_WTA), 1024, 32 * nb, scr, lane); continue; } r -= I_A;
        if (r < I_AO) { const int kb = r / 32, nb = r % 32; transpose_item((const GAS float*)a.a_w_out, 1024, 64 * kb, 32 * nb, nullptr, (GAS bf16*)(ws + WS_WTAO), 1024, 32 * nb, scr, lane); continue; } r -= I_AO;
        if (r < I_BQK) { const int kb = r / 64, nb = r % 64; transpose_item((const GAS float*)a.b_w_in, 3088, 64 * kb, 32 * nb, (const GAS float*)a.b_norm, (GAS bf16*)(ws + WS_WTB), 1024, 32 * nb, scr, lane); continue; } r -= I_BQK;
        if (r < I_BV) { const int kb = r / 32, nb = r % 32; transpose_item((const GAS float*)a.b_w_in, 3088, 64 * kb, 2048 + 32 * nb, (const GAS float*)a.b_norm, (GAS bf16*)(ws + WS_WTBV), 1024, 32 * nb, scr, lane); continue; } r -= I_BV;
        if (r < I_BO) { const int kb = r / 32, nb = r % 32; transpose_item((const GAS float*)a.b_w_out, 1024, 64 * kb, 32 * nb, nullptr, (GAS bf16*)(ws + WS_WTBO), 1024, 32 * nb, scr, lane); continue; } r -= I_BO;
        if (r < 2 * I_GU) { const int l = r / I_GU, q = r % I_GU, kb = q / 176, nb = q % 176, n0 = 32 * nb;
            const int drow = (n0 < FF) ? (256 * (n0 / 128) + (n0 % 128)) : (256 * ((n0 - FF) / 128) + 128 + ((n0 - FF) % 128));
            transpose_item((const GAS float*)a.ffn_w_gu + (size_t)l * 1024 * 5632, 5632, 64 * kb, n0, (const GAS float*)a.ffn_norm + l * 1024, (GAS bf16*)(ws + WS_WTGU + l * SZ_WTGU), 1024, drow, scr, lane); continue; } r -= 2 * I_GU;
        { const int l = r / I_D, q = r % I_D, kb = q / 32, nb = q % 32;
            transpose_item((const GAS float*)a.ffn_w_down + (size_t)l * 2816 * 1024, 1024, 64 * kb, 32 * nb, nullptr, (GAS bf16*)(ws + WS_WTD + l * SZ_WTD), 2816, 32 * nb, scr, lane); }
    }
    { GAS bf16* wtb = (GAS bf16*)(ws + WS_WTB);
      for (int i = gt; i < 16 * 1024; i += NGT) { const int col = i >> 10, k = i & 1023; wtb[(size_t)(2048 + col) * 1024 + k] = (bf16)f2bf(((const GAS float*)a.b_w_in)[(size_t)k * 3088 + 3072 + col] * ((const GAS float*)a.b_norm)[k]); }
      GAS v4u* z = (GAS v4u*)(wtb + (size_t)2064 * 1024); for (int i = gt; i < 240 * 1024 / 8; i += NGT) z[i] = (v4u){0u, 0u, 0u, 0u}; }
    { GAS float* rot = (GAS float*)(ws + WS_ROT);
      for (int i = gt; i < 4096 * 8; i += NGT) { const int s = i >> 3, d = i & 7; const float invf = exp2f(-(float)d * 0.125f * 18.931568569324174f);
          const float ang = (float)s * invf; const float k = rintf(ang * 0.15915494309189535f); float rr = fmaf(-k, 6.28125f, ang); rr = fmaf(-k, 0.0019353071795864769f, rr);
          rot[2 * i] = __builtin_amdgcn_cosf(rr * 0.15915494309189535f); rot[2 * i + 1] = __builtin_amdgcn_sinf(rr * 0.15915494309189535f); } }
    { GAS bf16* xb = (GAS bf16*)(ws + WS_XB); GAS float* rsp = (GAS float*)(ws + WS_RSP);
      for (int row0 = gw * 4; row0 < MT; row0 += NGW * 4) {
          f32x4 v[4][4]; float sq[4];
#pragma unroll
          for (int q = 0; q < 4; ++q) { const GAS f32x4* xr = (const GAS f32x4*)((const GAS float*)a.x + (size_t)(row0 + q) * 1024) + lane;
#pragma unroll
              for (int j = 0; j < 4; ++j) v[q][j] = xr[64 * j]; }
#pragma unroll
          for (int q = 0; q < 4; ++q) { float s = 0.f;
#pragma unroll
              for (int j = 0; j < 4; ++j) s += (v[q][j][0] * v[q][j][0] + v[q][j][1] * v[q][j][1]) + (v[q][j][2] * v[q][j][2] + v[q][j][3] * v[q][j][3]);
              sq[q] = s; }
#pragma unroll
          for (int o = 1; o < 64; o <<= 1) {
#pragma unroll
              for (int q = 0; q < 4; ++q) sq[q] += __shfl_xor(sq[q], o); }
#pragma unroll
          for (int q = 0; q < 4; ++q) { const int row = row0 + q; const float r = 1.0f / sqrtf(sq[q] * (1.0f / 1024.0f) + RMS_EPS);
              GAS unsigned long long* o8 = (GAS unsigned long long*)(xb + (size_t)row * 1024) + lane;
#pragma unroll
              for (int j = 0; j < 4; ++j) o8[64 * j] = (unsigned long long)pk2(v[q][j][0], v[q][j][1]) | ((unsigned long long)pk2(v[q][j][2], v[q][j][3]) << 32);
              if (lane < 3) { const int lgd = 2 * lane, lgL = 12 - lgd, b = row >> 12, s_ = row & 4095; rsp[(size_t)lane * MT + b * 4096 + ((s_ & ((1 << lgd) - 1)) << lgL) + (s_ >> lgd)] = r; } }
      } }
}

__device__ __forceinline__ void final_norm_phase(const GAS float* fnorm, GAS float* outp, int bid, const GAS bf16* hb, const GAS float* ss, int lane, int wave) {
    const int gw = bid * NWAVES + wave, NGW = gridDim.x * NWAVES;
    f32x4 gn[4];
#pragma unroll
    for (int j = 0; j < 4; ++j) gn[j] = ((const GAS f32x4*)fnorm)[lane + 64 * j];
    for (int row0 = gw * 4; row0 < MT; row0 += NGW * 4) {
        unsigned long long w[4][4]; float r[4];
#pragma unroll
        for (int q = 0; q < 4; ++q) { const GAS unsigned long long* h8 = (const GAS unsigned long long*)(hb + (size_t)(row0 + q) * 1024) + lane;
#pragma unroll
            for (int j = 0; j < 4; ++j) w[q][j] = h8[64 * j]; }
#pragma unroll
        for (int q = 0; q < 4; ++q) { const GAS f32x4* p = (const GAS f32x4*)(ss + (size_t)(row0 + q) * 16); const f32x4 s0 = p[0], s1 = p[1], s2 = p[2], s3 = p[3];
            const float t = ((s0[0] + s0[1]) + (s0[2] + s0[3])) + ((s1[0] + s1[1]) + (s1[2] + s1[3])) + ((s2[0] + s2[1]) + (s2[2] + s2[3])) + ((s3[0] + s3[1]) + (s3[2] + s3[3]));
            r[q] = 1.0f / sqrtf(t * (1.0f / 1024.0f) + RMS_EPS); }
#pragma unroll
        for (int q = 0; q < 4; ++q) { GAS f32x4* o = (GAS f32x4*)(outp + (size_t)(row0 + q) * 1024) + lane;
#pragma unroll
            for (int j = 0; j < 4; ++j) { const unsigned lo = (unsigned)w[q][j], hi = (unsigned)(w[q][j] >> 32);
                const f32x4 v = (f32x4){__uint_as_float(lo << 16), __uint_as_float(lo & 0xffff0000u), __uint_as_float(hi << 16), __uint_as_float(hi & 0xffff0000u)};
                o[64 * j] = v * r[q] * gn[j]; } }
    }
}


__device__ __forceinline__ void fgate_pass(const GAS bf16* hb, const GAS bf16* wf, const GAS float* ss, const GAS float* bf, GAS float* lf, int bid, int wave, int lane) {
    typedef short bf16x8v __attribute__((ext_vector_type(8)));
    const int fr = lane & 15, fq = lane >> 4;
    for (int rb = bid * NWAVES + wave; rb < MT / 16; rb += (int)gridDim.x * NWAVES) {
        const int row = rb * 16 + fr;
        const GAS bf16* ap = hb + (size_t)row * 1024 + 8 * fq; const GAS bf16* bp = wf + (size_t)fr * 1024 + 8 * fq;
        const GAS f32x4* sp = (const GAS f32x4*)(ss + (size_t)row * 16); const f32x4 s0 = sp[0], s1 = sp[1], s2 = sp[2], s3 = sp[3];
        f32x4 acc = {0.f, 0.f, 0.f, 0.f};
#pragma unroll
        for (int kb = 0; kb < 2; ++kb) {
            bf16x8v af[16], wf16[16];
#pragma unroll
            for (int k = 0; k < 16; ++k) { af[k] = *(const GAS bf16x8v*)(ap + 32 * (16 * kb + k)); wf16[k] = *(const GAS bf16x8v*)(bp + 32 * (16 * kb + k)); }
            asm volatile("" :: "v"(af[15]), "v"(wf16[15]));
#pragma unroll
            for (int k = 0; k < 16; ++k) acc = __builtin_amdgcn_mfma_f32_16x16x32_bf16(wf16[k], af[k], acc, 0, 0, 0); }
        const float t = ((s0[0] + s0[1]) + (s0[2] + s0[3])) + ((s1[0] + s1[1]) + (s1[2] + s1[3])) + ((s2[0] + s2[1]) + (s2[2] + s2[3])) + ((s3[0] + s3[1]) + (s3[2] + s3[3]));
        const float r = __builtin_amdgcn_rsqf(t * (1.0f / 1024.0f) + RMS_EPS);
        const f32x4 bv = *(const GAS f32x4*)(bf + 4 * fq); f32x4 o;
#pragma unroll
        for (int j = 0; j < 4; ++j) { const float x = acc[j] * r + bv[j]; const float e = __builtin_amdgcn_exp2f(-fabsf(x) * LOG2E); o[j] = fminf(x, 0.f) * LOG2E - __builtin_amdgcn_logf(1.0f + e); }
        *(GAS f32x4*)(lf + (size_t)row * 16 + 4 * fq) = o;
    }
}

template <class Epi> __device__ __forceinline__ void run_gemm(int tid, int bid, LAS unsigned char* lds, const GAS bf16* A, const GAS bf16* Bt, int Mr, int N, int K, int adil, int bdil, const Epi& E) {
    pg8::Gemm g{A, Bt, Mr, N, K, adil, bdil}; pg8::StaticOrder S; S.init(Mr, N, (int)gridDim.x, bid);
    pg8::gemm_phase<Epi, pg8::StaticOrder, true, true>(lds, g, S, E, tid);
}

#ifndef PHMASK
#define PHMASK 0xffff
#endif
#define PHON(k) (((PHMASK) >> (k)) & 1)
__device__ __forceinline__ unsigned long long stash_ld(LAS unsigned char* lds, int i) { const LAS unsigned* p = (const LAS unsigned*)(lds + 147456 - 128) + 2 * i; const unsigned lo = p[0], hi = p[1];
    return ((unsigned long long)(unsigned)__builtin_amdgcn_readfirstlane((int)hi) << 32) | (unsigned)__builtin_amdgcn_readfirstlane((int)lo); }
__global__ void __launch_bounds__(NWAVES * 64, 2) mega_fwd(Args a) {
    extern __shared__ __attribute__((aligned(16))) unsigned char lds_raw[];
    LAS unsigned char* lds = (LAS unsigned char*)lds_raw;
    cg::grid_group grid = cg::this_grid();

    volatile LAS unsigned* bst = (volatile LAS unsigned*)(lds + 147456 - 64);
    if (threadIdx.x < 2) bst[threadIdx.x] = 0u;
    if (threadIdx.x == 0) { LAS unsigned long long* stash = (LAS unsigned long long*)(lds + 147456 - 128);
        stash[0] = (unsigned long long)(uintptr_t)a.x; stash[1] = (unsigned long long)(uintptr_t)a.b_f; stash[2] = (unsigned long long)(uintptr_t)a.final_norm; stash[3] = (unsigned long long)(uintptr_t)a.out; }
    __syncthreads();
    XcdBarrier xbar = xcd_barrier_post((unsigned*)(a.ws + WS_BAR), bst);
    if (a.ph_hi == -12345) grid.sync();
    {
        int tid = threadIdx.x; asm volatile("" : "+v"(tid));
        const int lane = tid & 63, wave = __builtin_amdgcn_readfirstlane(tid >> 6);
        prologue(a, (GAS unsigned char*)a.ws, (int)blockIdx.x, lds, tid, lane, wave);
        xcd_barrier(xbar);
    }
    for (int ph = (a.ph_lo > 1 ? a.ph_lo : 1); ph < a.ph_hi; ++ph) {
#ifdef REPMASK
        for (int rep = 0; rep < 1 + ((REPMASK >> ph) & 1); ++rep)
#endif
        {
        int tid = threadIdx.x; asm volatile("" : "+v"(tid));
        const int lane = tid & 63, wave = __builtin_amdgcn_readfirstlane(tid >> 6);
        int bid = blockIdx.x; asm volatile("" : "+s"(bid));
        unsigned char* ws0 = a.ws; asm volatile("" : "+s"(ws0));
        GAS unsigned char* ws = (GAS unsigned char*)ws0;
        GAS bf16* XB = (GAS bf16*)(ws + WS_XB); GAS bf16* OB = (GAS bf16*)(ws + WS_O); GAS bf16* QK = (GAS bf16*)(ws + WS_QK); GAS bf16* VT = (GAS bf16*)(ws + WS_VT); GAS bf16* ACT = (GAS bf16*)(ws + WS_ACT);
        GAS float* LSE = (GAS float*)(ws + WS_LSE); GAS float* LF = (GAS float*)(ws + WS_LF);
        if (PHON(1) && (ph == 1 || ph == 2 || ph == 4 || ph == 6)) {
            const int ga = (ph - 2) >> 1, gq = (ph == 1) ? 0 : ga + 1;
            if (ph != 1) { GAS bf16* qk = (ga & 1) ? (GAS bf16*)stash_ld(lds, 3) : QK; GAS bf16* vt = (ga & 1) ? (GAS bf16*)(ws + 400 * MiB) : VT;
                const int G = gridDim.x; const int v = (G % 8 == 0) ? (int)((bid % 8) * (G / 8) + bid / 8) : bid; att::attn0_phase(ga, v, qk, vt, OB, LSE, lds, wave, lane); }
            if (gq < 3) { GAS bf16* qk = (gq & 1) ? (GAS bf16*)stash_ld(lds, 3) : QK; GAS bf16* vt = (gq & 1) ? (GAS bf16*)(ws + 400 * MiB) : VT;
                const int dil = 1 << (2 * gq); const GAS bf16* wt = (const GAS bf16*)(ws + WS_WTA) + (size_t)gq * 3072 * 1024; const GAS float* rsp = (const GAS float*)(ws + WS_RSP) + (size_t)gq * MT;
                { pg8::EpiQK0 E{qk, rsp, (const GAS float*)(ws + WS_ROT), 2 * gq}; run_gemm(tid, bid, lds, XB, wt, MT, 2048, 1024, dil, 1, E); }
                { pg8::EpiVT E{vt, rsp, nullptr}; run_gemm(tid, bid, lds, wt + (size_t)2048 * 1024, XB, 1024, MT, 1024, 1, dil, E); } }
        } else if (PHON(7) && (ph == 7 || ph == 12)) {
            const int l = (ph == 12); const GAS bf16* wt = (const GAS bf16*)(ws + (l ? WS_WTBO : WS_WTAO));
            pg8::EpiRes E{l ? (const GAS float*)nullptr : (const GAS float*)stash_ld(lds, 0), XB, (GAS float*)(ws + WS_SS + (size_t)(2 * l) * SZ_SS)}; run_gemm(tid, bid, lds, OB, wt, MT, 1024, 1024, 1, 1, E);
        } else if (PHON(8) && (ph == 8 || ph == 13)) {
            const int l = (ph == 13); pg8::EpiSwiglu E{ACT, (const GAS float*)(ws + WS_SS + (size_t)(2 * l) * SZ_SS)};
            run_gemm(tid, bid, lds, XB, (const GAS bf16*)(ws + WS_WTGU + l * SZ_WTGU), MT, 5632, 1024, 1, 1, E);
        } else if (PHON(9) && (ph == 9 || ph == 14)) {
            const int l = (ph == 14); pg8::EpiRes E{(const GAS float*)nullptr, XB, (GAS float*)(ws + WS_SS + (size_t)(2 * l + 1) * SZ_SS)};
            run_gemm(tid, bid, lds, ACT, (const GAS bf16*)(ws + WS_WTD + l * SZ_WTD), MT, 1024, 2816, 1, 1, E);
        } else if (PHON(10) && ph == 10) {
            const GAS float* ss = (const GAS float*)(ws + WS_SS + SZ_SS);
            fgate_pass(XB, (const GAS bf16*)(ws + WS_WTB) + (size_t)2048 * 1024, ss, (const GAS float*)stash_ld(lds, 1), LF, bid, wave, lane);
            { pg8::EpiQKB E{QK, ss, (const GAS float*)stash_ld(lds, 1), LF}; run_gemm(tid, bid, lds, XB, (const GAS bf16*)(ws + WS_WTB), MT, 2048, 1024, 1, 1, E); }
            { pg8::EpiVT E{VT, nullptr, ss}; run_gemm(tid, bid, lds, (const GAS bf16*)(ws + WS_WTBV), XB, 1024, MT, 1024, 1, 1, E); }
        } else if (PHON(11) && ph == 11) {
            const int G = gridDim.x; const int v = (G % 8 == 0) ? (int)((bid % 8) * (G / 8) + bid / 8) : bid;
            LAS float* cs = (LAS float*)lds; LAS float* wsum = cs + 4096;
            for (int su = v; su < 256; su += G) {
                const int bh = su >> 1, b = bh >> 4, h = bh & 15, set = su & 1;
                __syncthreads();
                float vl[8]; const GAS float* lp = LF + (size_t)(b * 4096 + 8 * tid) * 16 + h;
#pragma unroll
                for (int i = 0; i < 8; ++i) vl[i] = lp[i * 16];
#pragma unroll
                for (int i = 1; i < 8; ++i) vl[i] += vl[i - 1];
                float xs = vl[7];
#pragma unroll
                for (int o = 1; o < 64; o <<= 1) { const float t = __shfl_up(xs, o); if (lane >= o) xs += t; }
                if (lane == 63) wsum[wave] = xs;
                __syncthreads();
                float off = xs - vl[7];
                for (int w = 0; w < wave; ++w) off += wsum[w];
#pragma unroll
                for (int i = 0; i < 8; ++i) cs[8 * tid + i] = -(vl[i] + off);
                __syncthreads();
                for (int ui = 0; ui < 8; ++ui) { const int k = ui >> 1; const int qb = (ui & 1) ? (15 - 2 * k - set) : (2 * k + set); att::fox_unit3(b, h, qb, QK, VT, OB, cs, lds + 32768, wave, lane); }
            }
        } else if (PHON(15) && ph == 15) {
            final_norm_phase((const GAS float*)stash_ld(lds, 2), (GAS float*)stash_ld(lds, 3), bid, XB, (const GAS float*)(ws + WS_SS + 3 * SZ_SS), lane, wave);
        }
        }
        if (ph + 1 < a.ph_hi && ph != 3 && ph != 5) xcd_barrier(xbar);
    }
}

#ifndef MK_N_LAUNCHES
#define MK_N_LAUNCHES 1
#endif
extern "C" void kernel_launch(void* const* d_in, const int* in_sizes, int n_in, void* d_out, int out_size, void* d_ws, size_t ws_size, hipStream_t stream) {
    static int grid = 0;
    if (grid == 0) {
        if (n_in != 12 || out_size != MT * DM || ws_size < WS_END) { fprintf(stderr, "kernel_launch: unexpected problem (n_in %d out %d ws %zu)\n", n_in, out_size, ws_size); grid = -1; return; }
        int dev = 0, cus = 0, per_cu = 0;
        (void)hipGetDevice(&dev); (void)hipDeviceGetAttribute(&cus, hipDeviceAttributeMultiprocessorCount, dev);
        (void)hipFuncSetAttribute((const void*)mega_fwd, hipFuncAttributeMaxDynamicSharedMemorySize, LDS_BYTES);
        if (hipOccupancyMaxActiveBlocksPerMultiprocessor(&per_cu, (const void*)mega_fwd, NWAVES * 64, LDS_BYTES) != hipSuccess || per_cu < 1) per_cu = 1;
        (void)hipGetLastError();
        grid = cus * per_cu; if (grid <= 0) grid = 256;
    }
    if (grid < 0) return;
    (void)hipMemsetAsync((unsigned char*)d_ws + WS_BAR, 0, XCD_BAR_WORDS * sizeof(unsigned), stream);
    Args a{};
    a.x = (const float*)d_in[0]; a.a_norm = (const float*)d_in[1]; a.a_w_in = (const float*)d_in[2]; a.a_w_out = (const float*)d_in[3]; a.b_norm = (const float*)d_in[4]; a.b_w_in = (const float*)d_in[5];
    a.b_f = (const float*)d_in[6]; a.b_w_out = (const float*)d_in[7]; a.ffn_norm = (const float*)d_in[8]; a.ffn_w_gu = (const float*)d_in[9]; a.ffn_w_down = (const float*)d_in[10]; a.final_norm = (const float*)d_in[11];
    a.out = (float*)d_out; a.ws = (unsigned char*)d_ws;
#if MK_N_LAUNCHES == 1
    a.ph_lo = 0; a.ph_hi = NPH; void* args[] = {&a};
    hipError_t e = hipLaunchCooperativeKernel((const void*)mega_fwd, dim3(grid), dim3(NWAVES * 64), args, LDS_BYTES, stream);
    if (e != hipSuccess) fprintf(stderr, "cooperative launch failed: %s (grid %d)\n", hipGetErrorString(e), grid);
#else
    for (int p = 0; p < NPH; ++p) { a.ph_lo = p; a.ph_hi = p + 1; hipLaunchKernelGGL(mega_fwd, dim3(grid), dim3(NWAVES * 64), LDS_BYTES, stream, a); }
#endif
}
```

```cpp
#include <hip/hip_runtime.h>
#include <hip/hip_cooperative_groups.h>
#include <cstdio>
#include <cstdint>
namespace cg = cooperative_groups;

constexpr int NB = 8, SEQ = 4096, DM = 1024, MT = NB * SEQ, NH = 16, HD = 64, FF = 2816;
constexpr float RMS_EPS = 1e-6f;
constexpr float LOG2E = 1.4426950408889634f;
constexpr float QSCALE = 0.125f * LOG2E;
#define LAS __attribute__((address_space(3)))
#define GAS __attribute__((address_space(1)))

namespace pg8 {
#define PG8_LAS __attribute__((address_space(3)))
typedef unsigned short bf16_t;
typedef short bf16x8 __attribute__((ext_vector_type(8)));
typedef float f32x4 __attribute__((ext_vector_type(4)));
typedef unsigned u32x4 __attribute__((ext_vector_type(4)));
constexpr int BM = 256, BK = 64, HALF = 128, HTB = HALF * BK * 2  , STAGE_BYTES = 8 * HTB, NXCD = 8, WGM = 8;

__host__ __device__ __forceinline__ int lds_byte(int r, int c) { const int st = (r >> 4) * 2 + (c >> 5), rr = r & 15, cc = c & 31, ob = rr * 64 + cc * 2; return st * 1024 + (ob ^ (((ob >> 9) & 1) << 5)); }
__host__ __device__ __forceinline__ void stage_rc(int b, int& R, int& C) { const int st = b / 1024, sb = b % 1024, swz = sb ^ (((sb >> 9) & 1) << 5); R = (st >> 1) * 16 + swz / 64; C = (st & 1) * 32 + (swz % 64) / 2; }
__host__ __device__ __forceinline__ int perm32(int rho) { const int n = rho >> 4, i = rho & 15; return 8 * (i >> 2) + 4 * n + (i & 3); }

struct Unit { int pm, pn; };
struct Gemm { const GAS bf16_t* A; const GAS bf16_t* Bt; int M, N, K, adil, bdil; };
__device__ __forceinline__ int perm_tile_row(int tile, int dil) { const int rho0 = tile * 256, b = rho0 >> 12, w = rho0 & 4095, L = 4096 / dil, c = w / L, i0 = w % L; return b * 4096 + i0 * dil + c; }

struct StaticOrder {
    int nM, nN, nwg, G, c;
    __host__ __device__ void init(int M, int N, int G_, int c_) { nM = M / BM; nN = N / BM; nwg = nM * nN; G = G_; c = c_; }
    __host__ __device__ bool next(int i, Unit& u) const {
        const long L = (long)i * G + c; if (L >= nwg) return false;
        int wgid = (int)L; { const int q = nwg / NXCD, r = nwg % NXCD, xcd = wgid % NXCD, off = wgid / NXCD; wgid = (xcd < r ? xcd * (q + 1) : r * (q + 1) + (xcd - r) * q) + off; }
        const int nig = WGM * nN, gid = wgid / nig, fm = gid * WGM, gsz = (nM - fm) < WGM ? (nM - fm) : WGM;
        u.pm = fm + ((wgid % nig) % gsz); u.pn = (wgid % nig) / gsz; return true;
    }
    __device__ __forceinline__ void a_ready(const Unit&) const {}
    __device__ __forceinline__ void done(const Unit&) const {}
};

typedef float f32x2 __attribute__((ext_vector_type(2))); typedef __bf16 bf16x2v __attribute__((ext_vector_type(2)));
__device__ __forceinline__ unsigned cvt_pk_bf16(float lo, float hi) { const f32x2 v = {lo, hi}; const bf16x2v b = __builtin_convertvector(v, bf16x2v); return __builtin_bit_cast(unsigned, b); }
typedef unsigned u32x2 __attribute__((ext_vector_type(2)));
__device__ __forceinline__ u32x4 pack8(const f32x4 a, const f32x4 b) { u32x4 w; w.x = cvt_pk_bf16(a[0], a[1]); w.y = cvt_pk_bf16(a[2], a[3]); w.z = cvt_pk_bf16(b[0], b[1]); w.w = cvt_pk_bf16(b[2], b[3]); return w; }
__device__ __forceinline__ float row_rs(const GAS float* ss, int row, int fq) {
    const f32x4 p = *(const GAS f32x4*)(ss + (size_t)row * 16 + 4 * fq); float t = (p[0] + p[1]) + (p[2] + p[3]);
    t += __shfl_xor(t, 16); t += __shfl_xor(t, 32); return __builtin_amdgcn_rsqf(t * (1.0f / 1024.0f) + 1e-6f);
}

__device__ __forceinline__ float fq_sum(float t) {
    auto a = __builtin_amdgcn_permlane16_swap(__float_as_uint(t), __float_as_uint(t), false, false); t = __uint_as_float(a[0]) + __uint_as_float(a[1]);
    auto b = __builtin_amdgcn_permlane32_swap(__float_as_uint(t), __float_as_uint(t), false, false); return __uint_as_float(b[0]) + __uint_as_float(b[1]);
}
__device__ __forceinline__ void rows_rs8(const GAS float* ss, int row0  , int fq, float (&rr)[2][4]) {
    f32x4 p[2][4];
#pragma unroll
    for (int ai = 0; ai < 2; ++ai)
#pragma unroll
        for (int m = 0; m < 4; ++m) p[ai][m] = *(const GAS f32x4*)(ss + (size_t)(row0 + ai * HALF + m * 16) * 16 + 4 * fq);
    asm volatile("" :: "v"(p[0][0]), "v"(p[0][1]), "v"(p[0][2]), "v"(p[0][3]), "v"(p[1][0]), "v"(p[1][1]), "v"(p[1][2]), "v"(p[1][3]));
#pragma unroll
    for (int ai = 0; ai < 2; ++ai)
#pragma unroll
        for (int m = 0; m < 4; ++m) { float t = (p[ai][m][0] + p[ai][m][1]) + (p[ai][m][2] + p[ai][m][3]);
            t = fq_sum(t); rr[ai][m] = __builtin_amdgcn_rsqf(t * (1.0f / 1024.0f) + 1e-6f); }
}

struct EpiQK0 {
    static constexpr bool PERM = true, AFTER_DRAIN = false;
    GAS bf16_t* out; const GAS float* rsp; const GAS float* rot; int lgd;
    __device__ __forceinline__ void operator()(const f32x4 (&acc)[2][2][4][2], const Unit& u, int wr, int wc, int fr, int fq) const {
        const int col0 = u.pn * BM + wc * 32 + 8 * fq; const bool rotw = (wc & 1) == 0; const float qs = (u.pn < 4) ? 0.125f * 1.4426950408889634f : 1.0f;
        const int lgL = 12 - lgd, Lm = (1 << lgL) - 1; const float sgn = (fq == 0) ? -1.0f : 1.0f; const bool rl = fq < 2;
        float rr[2][4];
#pragma unroll
        for (int ai = 0; ai < 2; ++ai)
#pragma unroll
            for (int m = 0; m < 4; ++m) rr[ai][m] = rsp[u.pm * BM + ai * HALF + wr * 64 + m * 16 + fr];
        asm volatile("" :: "v"(rr[0][0]), "v"(rr[0][1]), "v"(rr[0][2]), "v"(rr[0][3]), "v"(rr[1][0]), "v"(rr[1][1]), "v"(rr[1][2]), "v"(rr[1][3]));
#pragma unroll
        for (int ai = 0; ai < 2; ++ai)
#pragma unroll
            for (int m = 0; m < 4; ++m) rr[ai][m] *= qs;
#pragma unroll
        for (int ai = 0; ai < 2; ++ai)
#pragma unroll
            for (int mp = 0; mp < 2; ++mp) {
                f32x4 cs[2][4];
                if (rotw) {
#pragma unroll
                    for (int mm = 0; mm < 2; ++mm) { const int rho = u.pm * BM + ai * HALF + wr * 64 + (2 * mp + mm) * 16 + fr, w = rho & 4095, s = ((w & Lm) << lgd) + (w >> lgL);
                        const GAS f32x4* tp = (const GAS f32x4*)(rot + (size_t)s * 16);
#pragma unroll
                        for (int i = 0; i < 4; ++i) cs[mm][i] = tp[i]; }
                    asm volatile("" :: "v"(cs[0][0]), "v"(cs[0][1]), "v"(cs[0][2]), "v"(cs[0][3]), "v"(cs[1][0]), "v"(cs[1][1]), "v"(cs[1][2]), "v"(cs[1][3])); }
#pragma unroll
                for (int mm = 0; mm < 2; ++mm) { const int m = 2 * mp + mm;
                    const int rho = u.pm * BM + ai * HALF + wr * 64 + m * 16 + fr; const float r = rr[ai][m];
#pragma unroll
                    for (int bj = 0; bj < 2; ++bj) { f32x4 v[2];
#pragma unroll
                        for (int n = 0; n < 2; ++n) { v[n] = acc[ai][bj][m][n] * r;
                            if (rotw) { const f32x4 ca = cs[mm][2 * n], cb = cs[mm][2 * n + 1]; f32x4 p;
#pragma unroll
                                for (int j = 0; j < 4; ++j) { auto sw = __builtin_amdgcn_permlane16_swap(__float_as_uint(v[n][j]), __float_as_uint(v[n][j]), false, false); p[j] = __uint_as_float((fq & 1) ? sw[0] : sw[1]); }
                                if (rl) { v[n][0] = v[n][0] * ca[0] + sgn * p[0] * ca[1]; v[n][1] = v[n][1] * ca[2] + sgn * p[1] * ca[3];
                                          v[n][2] = v[n][2] * cb[0] + sgn * p[2] * cb[1]; v[n][3] = v[n][3] * cb[2] + sgn * p[3] * cb[3]; } } }
                        *(GAS u32x4*)(out + (size_t)rho * 2048 + col0 + bj * HALF) = pack8(v[0], v[1]); }
                }
            }
    }
};
struct EpiVT {
    static constexpr bool PERM = true, AFTER_DRAIN = false;
    GAS bf16_t* vt; const GAS float* rsp; const GAS float* ss;
    __device__ __forceinline__ void operator()(const f32x4 (&acc)[2][2][4][2], const Unit& u, int wr, int wc, int fr, int fq) const {
        const int rho0 = u.pn * BM + wc * 32 + 8 * fq; float rt = 0.f;
        if (!rsp) {
            const int tok = rho0 + (fr >> 3) * HALF + (fr & 7); const GAS f32x4* p = (const GAS f32x4*)(ss + (size_t)tok * 16);
            const f32x4 a = p[0], b = p[1], c = p[2], d = p[3];
            const float t = ((a[0] + a[1]) + (a[2] + a[3])) + ((b[0] + b[1]) + (b[2] + b[3])) + ((c[0] + c[1]) + (c[2] + c[3])) + ((d[0] + d[1]) + (d[2] + d[3]));
            rt = __builtin_amdgcn_rsqf(t * (1.0f / 1024.0f) + 1e-6f); }
        const int b = rho0 >> 12, w = rho0 & 4095, lb = (fq << 4);
#pragma unroll
        for (int bj = 0; bj < 2; ++bj) { float sc[8];
            if (rsp) { const f32x4 a = *(const GAS f32x4*)(rsp + rho0 + bj * HALF), b2 = *(const GAS f32x4*)(rsp + rho0 + bj * HALF + 4);
#pragma unroll
                for (int j = 0; j < 4; ++j) { sc[j] = a[j]; sc[4 + j] = b2[j]; } }
            else {
#pragma unroll
                for (int k = 0; k < 8; ++k) sc[k] = __shfl(rt, lb + bj * 8 + k); }
#pragma unroll
            for (int ai = 0; ai < 2; ++ai)
#pragma unroll
                for (int m = 0; m < 4; ++m) { const int f = u.pm * BM + ai * HALF + wr * 64 + m * 16 + fr; GAS bf16_t* rowp = vt + ((size_t)(b * 1024 + f)) * 4096 + w;
                    f32x4 v0 = acc[ai][bj][m][0], v1 = acc[ai][bj][m][1];
#pragma unroll
                    for (int j = 0; j < 4; ++j) { v0[j] *= sc[j]; v1[j] *= sc[4 + j]; }
                    *(GAS u32x4*)(rowp + bj * HALF) = pack8(v0, v1); } }
    }
};
struct EpiRes {
    static constexpr bool PERM = true, AFTER_DRAIN = false;
    const GAS float* resf; GAS bf16_t* hb; GAS float* ss;
    __device__ __forceinline__ void operator()(const f32x4 (&acc)[2][2][4][2], const Unit& u, int wr, int wc, int fr, int fq) const {
        const int col0 = u.pn * BM + wc * 32 + 8 * fq;
#pragma unroll
        for (int ai = 0; ai < 2; ++ai) {
            f32x4 r0[4][2], r1[4][2];
            if (resf) {
#pragma unroll
                for (int m = 0; m < 4; ++m)
#pragma unroll
                    for (int bj = 0; bj < 2; ++bj) { const size_t off = (size_t)(u.pm * BM + ai * HALF + wr * 64 + m * 16 + fr) * 1024 + col0 + bj * HALF;
                        r0[m][bj] = *(const GAS f32x4*)(resf + off); r1[m][bj] = *(const GAS f32x4*)(resf + off + 4); }
            } else { u32x4 w[4][2];
#pragma unroll
                for (int m = 0; m < 4; ++m)
#pragma unroll
                    for (int bj = 0; bj < 2; ++bj) w[m][bj] = *(const GAS u32x4*)(hb + (size_t)(u.pm * BM + ai * HALF + wr * 64 + m * 16 + fr) * 1024 + col0 + bj * HALF);
                asm volatile("" :: "v"(w[0][0]), "v"(w[0][1]), "v"(w[1][0]), "v"(w[1][1]), "v"(w[2][0]), "v"(w[2][1]), "v"(w[3][0]), "v"(w[3][1]));
#pragma unroll
                for (int m = 0; m < 4; ++m)
#pragma unroll
                    for (int bj = 0; bj < 2; ++bj) { const u32x4 x = w[m][bj];
                        r0[m][bj] = (f32x4){__uint_as_float(x.x << 16), __uint_as_float(x.x & 0xffff0000u), __uint_as_float(x.y << 16), __uint_as_float(x.y & 0xffff0000u)};
                        r1[m][bj] = (f32x4){__uint_as_float(x.z << 16), __uint_as_float(x.z & 0xffff0000u), __uint_as_float(x.w << 16), __uint_as_float(x.w & 0xffff0000u)}; } }
#pragma unroll
            for (int m = 0; m < 4; ++m) { const int row = u.pm * BM + ai * HALF + wr * 64 + m * 16 + fr; float q = 0.f;
#pragma unroll
                for (int bj = 0; bj < 2; ++bj) { const size_t off = (size_t)row * 1024 + col0 + bj * HALF;
                    const f32x4 v0 = acc[ai][bj][m][0] + r0[m][bj], v1 = acc[ai][bj][m][1] + r1[m][bj];
                    q += (v0[0] * v0[0] + v0[1] * v0[1]) + (v0[2] * v0[2] + v0[3] * v0[3]) + (v1[0] * v1[0] + v1[1] * v1[1]) + (v1[2] * v1[2] + v1[3] * v1[3]);
                    *(GAS u32x4*)(hb + off) = pack8(v0, v1); }
                q = fq_sum(q);
                if (fq == 0) ss[(size_t)row * 16 + u.pn * 4 + wc] = q; }
        }
    }
};
struct EpiSwiglu {
    static constexpr bool PERM = true, AFTER_DRAIN = false;
    GAS bf16_t* act; const GAS float* ss;
    __device__ __forceinline__ void operator()(const f32x4 (&acc)[2][2][4][2], const Unit& u, int wr, int wc, int fr, int fq) const {
        const int col0 = u.pn * HALF + wc * 32 + 8 * fq; float rr[2][4];
        rows_rs8(ss, u.pm * BM + wr * 64 + fr, fq, rr);
#pragma unroll
        for (int ai = 0; ai < 2; ++ai)
#pragma unroll
            for (int m = 0; m < 4; ++m) { const int row = u.pm * BM + ai * HALF + wr * 64 + m * 16 + fr; const float r = rr[ai][m];
                f32x4 o[2];
#pragma unroll
                for (int n = 0; n < 2; ++n) { const f32x4 gg = acc[ai][0][m][n] * r, uu = acc[ai][1][m][n] * r;
#pragma unroll
                    for (int j = 0; j < 4; ++j) { const float e = __builtin_amdgcn_exp2f(gg[j] * -1.4426950408889634f); o[n][j] = gg[j] * uu[j] * __builtin_amdgcn_rcpf(1.0f + e); } }
                *(GAS u32x4*)(act + (size_t)row * 2816 + col0) = pack8(o[0], o[1]); }
    }
};
struct EpiQKB {
    static constexpr bool PERM = true, AFTER_DRAIN = false;
    GAS bf16_t* out; const GAS float* ss; const GAS float* bf; GAS float* lf;
    __device__ __forceinline__ void operator()(const f32x4 (&acc)[2][2][4][2], const Unit& u, int wr, int wc, int fr, int fq) const {
        const int col0 = u.pn * BM + wc * 32 + 8 * fq; const float qs = (u.pn < 4) ? 0.125f * 1.4426950408889634f : 1.0f; float rr[2][4];
        rows_rs8(ss, u.pm * BM + wr * 64 + fr, fq, rr);
#pragma unroll
        for (int ai = 0; ai < 2; ++ai)
#pragma unroll
            for (int m = 0; m < 4; ++m) { const int row = u.pm * BM + ai * HALF + wr * 64 + m * 16 + fr; const float r0 = rr[ai][m], r = r0 * qs;
                if (u.pn < 8) {
#pragma unroll
                    for (int bj = 0; bj < 2; ++bj) *(GAS u32x4*)(out + (size_t)row * 2048 + col0 + bj * HALF) = pack8(acc[ai][bj][m][0] * r, acc[ai][bj][m][1] * r);
                } else if (wc == 0 && fq < 2) {
                    f32x4 o[2];
#pragma unroll
                    for (int n = 0; n < 2; ++n)
#pragma unroll
                        for (int j = 0; j < 4; ++j) { const float x = acc[ai][0][m][n][j] * r0 + bf[8 * fq + 4 * n + j];
                            const float e = __builtin_amdgcn_exp2f(-fabsf(x) * 1.4426950408889634f); o[n][j] = fminf(x, 0.f) * 1.4426950408889634f - __builtin_amdgcn_logf(1.0f + e); }
                    *(GAS f32x4*)(lf + (size_t)row * 16 + 8 * fq) = o[0]; *(GAS f32x4*)(lf + (size_t)row * 16 + 8 * fq + 4) = o[1];
                } }
    }
};

template <class Epi, class Sched, bool ALIGN_EPI = false, bool SP2 = false>
__device__ __forceinline__ void gemm_phase(PG8_LAS unsigned char* lds, const Gemm g, const Sched& S, const Epi& E, const int tid) {
    const int wid = __builtin_amdgcn_readfirstlane(tid >> 6), lane = tid & 63, wr = wid >> 2, wc = wid & 3, fr = lane & 15, fq = lane >> 4;
    const int K = g.K, nt = K / BK;
    unsigned voffA[2], voffB[2];
#pragma unroll
    for (int i = 0; i < 2; ++i) { int R, C; stage_rc(tid * 16 + i * 8192, R, C); const int Rb = Epi::PERM ? ((R & ~31) + perm32(R & 31)) : R;
        voffA[i] = (unsigned)(R * g.adil * K + C) * 2u; voffB[i] = (unsigned)(Rb * g.bdil * K + C) * 2u; }
    const size_t kstep = (size_t)(BK * 2);
    const size_t hstepA = (size_t)HALF * g.adil * K * 2, hstepB = (size_t)HALF * g.bdil * K * 2;
    const unsigned ldsw = (unsigned)wid * 1024u;
    const int aoff = lds_byte(wr * 64 + fr, fq * 8), boff = lds_byte(wc * 32 + fr, fq * 8);
#define PG8_SA(b, h) (((b) * 2 + (h)) * HTB)
#define PG8_SB(b, h) ((4 + (b) * 2 + (h)) * HTB)
#define PG8_STAGE(bufoff, gbase, voff) do { _Pragma("unroll") for (int _i = 0; _i < 2; ++_i) \
        __builtin_amdgcn_global_load_lds((const GAS unsigned*)((const GAS char*)(gbase) + (voff)[_i]), (PG8_LAS unsigned*)(lds + (bufoff) + ldsw + _i * 8192), 16, 0, 0); } while (0)
#define PG8_LDA(dst, b, h) do { _Pragma("unroll") for (int m = 0; m < 4; ++m) _Pragma("unroll") for (int k = 0; k < 2; ++k) dst[m][k] = *(const PG8_LAS bf16x8*)(lds + PG8_SA(b, h) + aoff + m * 2048 + k * 1024); } while (0)
#define PG8_LDB(dst, b, h) do { _Pragma("unroll") for (int n = 0; n < 2; ++n) _Pragma("unroll") for (int k = 0; k < 2; ++k) dst[n][k] = *(const PG8_LAS bf16x8*)(lds + PG8_SB(b, h) + boff + n * 2048 + k * 1024); } while (0)
#define PG8_MMA(ai, bj, At, Bt) do { __builtin_amdgcn_s_setprio(1); _Pragma("unroll") for (int m = 0; m < 4; ++m) _Pragma("unroll") for (int n = 0; n < 2; ++n) _Pragma("unroll") for (int k = 0; k < 2; ++k) \
        acc[ai][bj][m][n] = __builtin_amdgcn_mfma_f32_16x16x32_bf16(Bt[n][k], At[m][k], acc[ai][bj][m][n], 0, 0, 0); __builtin_amdgcn_s_setprio(0); } while (0)
#define PG8_WAIT_V(n) asm volatile("s_waitcnt vmcnt(" #n ")" ::: "memory")
#define PG8_WAIT_L(n) asm volatile("s_waitcnt lgkmcnt(" #n ")" ::: "memory")
#define PG8_BAR __builtin_amdgcn_s_barrier()
#define PG8_SCHED __builtin_amdgcn_sched_barrier(0)
    Unit cur, nxt; int ui = 0;
    if (!S.next(0, cur)) return;
    f32x4 acc[2][2][4][2];
#pragma unroll
    for (int a = 0; a < 2; ++a)
#pragma unroll
        for (int b = 0; b < 2; ++b)
#pragma unroll
            for (int m = 0; m < 4; ++m)
#pragma unroll
                for (int n = 0; n < 2; ++n) acc[a][b][m][n] = (f32x4){0.f, 0.f, 0.f, 0.f};
    bf16x8 At[4][2], B0[2][2], B1[2][2];
    const GAS char* cA = (const GAS char*)g.A + (size_t)perm_tile_row(cur.pm, g.adil) * K * 2; const GAS char* cB = (const GAS char*)g.Bt + (size_t)perm_tile_row(cur.pn, g.bdil) * K * 2;
    S.a_ready(cur);
    if constexpr (SP2) {
        PG8_STAGE(PG8_SB(0, 0), cB, voffB); PG8_STAGE(PG8_SB(0, 1), cB + hstepB, voffB); PG8_STAGE(PG8_SA(0, 0), cA, voffA); PG8_STAGE(PG8_SA(0, 1), cA + hstepA, voffA);
        if (wr == 1) PG8_BAR;
        PG8_WAIT_V(2); PG8_BAR;
        PG8_STAGE(PG8_SB(1, 0), cB + kstep, voffB); PG8_STAGE(PG8_SA(1, 0), cA + kstep, voffA); PG8_STAGE(PG8_SB(1, 1), cB + hstepB + kstep, voffB);
        PG8_WAIT_V(6); PG8_BAR;
    } else {
        PG8_STAGE(PG8_SB(0, 0), cB, voffB); PG8_STAGE(PG8_SA(0, 0), cA, voffA); PG8_STAGE(PG8_SB(0, 1), cB + hstepB, voffB); PG8_STAGE(PG8_SA(0, 1), cA + hstepA, voffA);
        if (wr == 1) PG8_BAR;
        PG8_WAIT_V(4); PG8_BAR;
        PG8_STAGE(PG8_SB(1, 0), cB + kstep, voffB); PG8_STAGE(PG8_SA(1, 0), cA + kstep, voffA); PG8_STAGE(PG8_SB(1, 1), cB + hstepB + kstep, voffB);
        PG8_WAIT_V(6); PG8_BAR;
    }
    for (;;) {
        const bool has_next = S.next(ui + 1, nxt);
        const GAS char* nA = has_next ? (const GAS char*)g.A + (size_t)perm_tile_row(nxt.pm, g.adil) * K * 2 : cA; const GAS char* nB = has_next ? (const GAS char*)g.Bt + (size_t)perm_tile_row(nxt.pn, g.bdil) * K * 2 : cB;
        for (int t = 0; t < nt; t += 2) {
            const bool last = (t == nt - 2);
            const GAS char* a1 = cA + (size_t)(t + 1) * kstep;
            const GAS char* a2 = last ? nA : cA + (size_t)(t + 2) * kstep; const GAS char* b2 = last ? nB : cB + (size_t)(t + 2) * kstep;
            const GAS char* a3 = a2 + kstep; const GAS char* b3 = b2 + kstep;
            if (last && has_next) S.a_ready(nxt);
            if constexpr (SP2) {
            PG8_LDB(B0, 0, 0); PG8_LDB(B1, 0, 1); PG8_SCHED; PG8_LDA(At, 0, 0); PG8_STAGE(PG8_SA(1, 1), a1 + hstepA, voffA);
            PG8_WAIT_V(8); PG8_WAIT_L(0); PG8_BAR; PG8_MMA(0, 0, At, B0); PG8_MMA(0, 1, At, B1); PG8_BAR; PG8_SCHED;
            PG8_LDA(At, 0, 1); PG8_STAGE(PG8_SB(0, 0), b2, voffB); PG8_STAGE(PG8_SB(0, 1), b2 + hstepB, voffB); PG8_STAGE(PG8_SA(0, 0), a2, voffA);
            PG8_WAIT_V(8); PG8_WAIT_L(0); PG8_BAR; PG8_MMA(1, 0, At, B0); PG8_MMA(1, 1, At, B1); PG8_BAR; PG8_SCHED;
            PG8_LDB(B0, 1, 0); PG8_LDB(B1, 1, 1); PG8_SCHED; PG8_LDA(At, 1, 0); PG8_STAGE(PG8_SA(0, 1), a2 + hstepA, voffA);
            PG8_WAIT_V(8); PG8_WAIT_L(0); PG8_BAR; PG8_MMA(0, 0, At, B0); PG8_MMA(0, 1, At, B1); PG8_BAR; PG8_SCHED;
            PG8_LDA(At, 1, 1); PG8_STAGE(PG8_SB(1, 0), b3, voffB); PG8_STAGE(PG8_SB(1, 1), b3 + hstepB, voffB); PG8_STAGE(PG8_SA(1, 0), a3, voffA);
            PG8_WAIT_V(8); PG8_WAIT_L(0); PG8_BAR; PG8_MMA(1, 0, At, B0); PG8_MMA(1, 1, At, B1); PG8_BAR; PG8_SCHED;
            } else {
            PG8_LDB(B0, 0, 0); PG8_SCHED; PG8_LDA(At, 0, 0); PG8_STAGE(PG8_SA(1, 1), a1 + hstepA, voffA);
            PG8_WAIT_L(8); PG8_BAR; PG8_WAIT_L(0); PG8_MMA(0, 0, At, B0); PG8_BAR; PG8_SCHED;
            PG8_LDB(B1, 0, 1); PG8_STAGE(PG8_SB(0, 0), b2, voffB);
            PG8_BAR; PG8_WAIT_L(0); PG8_MMA(0, 1, At, B1); PG8_BAR;
            PG8_LDA(At, 0, 1); PG8_STAGE(PG8_SA(0, 0), a2, voffA);
            PG8_BAR; PG8_WAIT_L(0); PG8_MMA(1, 0, At, B0); PG8_BAR; PG8_SCHED;
            PG8_STAGE(PG8_SB(0, 1), b2 + hstepB, voffB);
            PG8_WAIT_V(6); PG8_BAR; PG8_MMA(1, 1, At, B1); PG8_BAR;
            PG8_LDB(B0, 1, 0); PG8_SCHED; PG8_LDA(At, 1, 0); PG8_STAGE(PG8_SA(0, 1), a2 + hstepA, voffA);
            PG8_WAIT_L(8); PG8_BAR; PG8_WAIT_L(0); PG8_MMA(0, 0, At, B0); PG8_BAR; PG8_SCHED;
            PG8_LDB(B1, 1, 1); PG8_STAGE(PG8_SB(1, 0), b3, voffB);
            PG8_BAR; PG8_WAIT_L(0); PG8_MMA(0, 1, At, B1); PG8_BAR;
            PG8_LDA(At, 1, 1); PG8_STAGE(PG8_SA(1, 0), a3, voffA);
            PG8_BAR; PG8_WAIT_L(0); PG8_MMA(1, 0, At, B0); PG8_BAR; PG8_SCHED;
            PG8_STAGE(PG8_SB(1, 1), b3 + hstepB, voffB);
            PG8_WAIT_V(6); PG8_BAR; PG8_MMA(1, 1, At, B1); PG8_BAR;
            }
        }
        if constexpr (ALIGN_EPI) { if (wr == 0) PG8_BAR; }
        if constexpr (!Epi::AFTER_DRAIN) { E(acc, cur, wr, wc, fr, fq); S.done(cur); }
        if (!has_next) break;
#pragma unroll
        for (int a = 0; a < 2; ++a)
#pragma unroll
            for (int b = 0; b < 2; ++b)
#pragma unroll
                for (int m = 0; m < 4; ++m)
#pragma unroll
                    for (int n = 0; n < 2; ++n) acc[a][b][m][n] = (f32x4){0.f, 0.f, 0.f, 0.f};
        cur = nxt; cA = nA; cB = nB; ++ui;
        if constexpr (ALIGN_EPI) { if (wr == 1) PG8_BAR; }
    }
    PG8_WAIT_V(0);
    if constexpr (!ALIGN_EPI) { if (wr == 0) PG8_BAR; }
    PG8_BAR;
    if constexpr (Epi::AFTER_DRAIN) { E.fused(acc, cur, wr, wc, fr, fq, lds, wid, lane); S.done(cur); }
#undef PG8_SA
#undef PG8_SB
#undef PG8_STAGE
#undef PG8_LDA
#undef PG8_LDB
#undef PG8_MMA
#undef PG8_WAIT_V
#undef PG8_WAIT_L
#undef PG8_BAR
#undef PG8_SCHED
}
}

namespace att {
typedef unsigned short bf16_t;
typedef short bf16x8 __attribute__((ext_vector_type(8)));
typedef float f32x16 __attribute__((ext_vector_type(16)));
typedef float f32x4 __attribute__((ext_vector_type(4)));
typedef unsigned u32x2 __attribute__((ext_vector_type(2)));
typedef unsigned u32x4 __attribute__((ext_vector_type(4)));
typedef float f32x2_t __attribute__((ext_vector_type(2))); typedef __bf16 bf16x2_t __attribute__((ext_vector_type(2)));
__device__ __forceinline__ unsigned cvtpk(float lo, float hi) { f32x2_t v = {lo, hi}; bf16x2_t b = __builtin_convertvector(v, bf16x2_t); return __builtin_bit_cast(unsigned, b); }
__device__ __forceinline__ float bflo(unsigned w) { return __uint_as_float(w << 16); }
__device__ __forceinline__ float bfhi(unsigned w) { return __uint_as_float(w & 0xffff0000u); }
constexpr float NEG = -1e30f;

struct KV { bf16x8 k[4]; bf16x8 v[2][2]; };
__device__ __forceinline__ void load_kv(KV& t, const GAS bf16_t* Kp, const GAS bf16_t* Vp, int key0) {
#pragma unroll
    for (int d0 = 0; d0 < 4; ++d0) t.k[d0] = *(const GAS bf16x8*)(Kp + (size_t)key0 * 2048 + 16 * d0);
#pragma unroll
    for (int dh = 0; dh < 2; ++dh)
#pragma unroll
        for (int kc = 0; kc < 2; ++kc) t.v[dh][kc] = *(const GAS bf16x8*)(Vp + (size_t)dh * 32 * 4096 + key0 + 16 * kc);
}
struct St { float m, l; f32x16 o0, o1; };
__device__ __forceinline__ f32x16 qk(const KV& t, const bf16x8 (&qf)[4], f32x16 s = f32x16{}) {
#pragma unroll
    for (int d0 = 0; d0 < 4; ++d0) s = __builtin_amdgcn_mfma_f32_32x32x16_bf16(t.k[d0], qf[d0], s, 0, 0, 0);
    return s;
}
__device__ __forceinline__ void upd(St& S, f32x16 st, const KV& t) {
    float mx = fmaxf(fmaxf(st[0], st[1]), fmaxf(st[2], st[3]));
#pragma unroll
    for (int r = 4; r < 16; r += 4) mx = fmaxf(mx, fmaxf(fmaxf(st[r], st[r + 1]), fmaxf(st[r + 2], st[r + 3])));
    mx = fmaxf(mx, __shfl_xor(mx, 32));
    const float mnew = fmaxf(S.m, mx), alpha = __builtin_amdgcn_exp2f(S.m - mnew); S.m = mnew;
    float ps = 0.f;
#pragma unroll
    for (int r = 0; r < 16; ++r) { st[r] = __builtin_amdgcn_exp2f(st[r] - mnew); ps += st[r]; }
    S.l = S.l * alpha + ps;
    if (__any(alpha != 1.0f)) { S.o0 *= alpha; S.o1 *= alpha; }
    u32x4 w0, w1;
    w0.x = cvtpk(st[0], st[1]); w0.y = cvtpk(st[2], st[3]); w0.z = cvtpk(st[4], st[5]); w0.w = cvtpk(st[6], st[7]);
    w1.x = cvtpk(st[8], st[9]); w1.y = cvtpk(st[10], st[11]); w1.z = cvtpk(st[12], st[13]); w1.w = cvtpk(st[14], st[15]);
    const bf16x8 p0 = __builtin_bit_cast(bf16x8, w0), p1 = __builtin_bit_cast(bf16x8, w1);
    S.o0 = __builtin_amdgcn_mfma_f32_32x32x16_bf16(t.v[0][0], p0, S.o0, 0, 0, 0); S.o0 = __builtin_amdgcn_mfma_f32_32x32x16_bf16(t.v[0][1], p1, S.o0, 0, 0, 0);
    S.o1 = __builtin_amdgcn_mfma_f32_32x32x16_bf16(t.v[1][0], p0, S.o1, 0, 0, 0); S.o1 = __builtin_amdgcn_mfma_f32_32x32x16_bf16(t.v[1][1], p1, S.o1, 0, 0, 0);
}
__device__ __forceinline__ void upd64(St& S, f32x16 s0, f32x16 s1, const KV& t0, const KV& t1) {
    float mx = fmaxf(fmaxf(s0[0], s0[1]), fmaxf(s1[0], s1[1]));
#pragma unroll
    for (int r = 2; r < 16; r += 2) mx = fmaxf(mx, fmaxf(fmaxf(s0[r], s0[r + 1]), fmaxf(s1[r], s1[r + 1])));
    mx = fmaxf(mx, __shfl_xor(mx, 32));
    const float mnew = fmaxf(S.m, mx), alpha = __builtin_amdgcn_exp2f(S.m - mnew); S.m = mnew;
    s0 = s0 - mnew; s1 = s1 - mnew;
    float pa = 0.f, pb = 0.f;
#pragma unroll
    for (int r = 0; r < 16; ++r) { s0[r] = __builtin_amdgcn_exp2f(s0[r]); s1[r] = __builtin_amdgcn_exp2f(s1[r]); pa += s0[r]; pb += s1[r]; }
    S.l = S.l * alpha + (pa + pb);
    if (__any(alpha != 1.0f)) { S.o0 *= alpha; S.o1 *= alpha; }
    u32x4 w0, w1, w2, w3;
    w0.x = cvtpk(s0[0], s0[1]); w0.y = cvtpk(s0[2], s0[3]); w0.z = cvtpk(s0[4], s0[5]); w0.w = cvtpk(s0[6], s0[7]);
    w1.x = cvtpk(s0[8], s0[9]); w1.y = cvtpk(s0[10], s0[11]); w1.z = cvtpk(s0[12], s0[13]); w1.w = cvtpk(s0[14], s0[15]);
    w2.x = cvtpk(s1[0], s1[1]); w2.y = cvtpk(s1[2], s1[3]); w2.z = cvtpk(s1[4], s1[5]); w2.w = cvtpk(s1[6], s1[7]);
    w3.x = cvtpk(s1[8], s1[9]); w3.y = cvtpk(s1[10], s1[11]); w3.z = cvtpk(s1[12], s1[13]); w3.w = cvtpk(s1[14], s1[15]);
    const bf16x8 p0 = __builtin_bit_cast(bf16x8, w0), p1 = __builtin_bit_cast(bf16x8, w1), p2 = __builtin_bit_cast(bf16x8, w2), p3 = __builtin_bit_cast(bf16x8, w3);
    S.o0 = __builtin_amdgcn_mfma_f32_32x32x16_bf16(t0.v[0][0], p0, S.o0, 0, 0, 0); S.o1 = __builtin_amdgcn_mfma_f32_32x32x16_bf16(t0.v[1][0], p0, S.o1, 0, 0, 0);
    S.o0 = __builtin_amdgcn_mfma_f32_32x32x16_bf16(t0.v[0][1], p1, S.o0, 0, 0, 0); S.o1 = __builtin_amdgcn_mfma_f32_32x32x16_bf16(t0.v[1][1], p1, S.o1, 0, 0, 0);
    S.o0 = __builtin_amdgcn_mfma_f32_32x32x16_bf16(t1.v[0][0], p2, S.o0, 0, 0, 0); S.o1 = __builtin_amdgcn_mfma_f32_32x32x16_bf16(t1.v[1][0], p2, S.o1, 0, 0, 0);
    S.o0 = __builtin_amdgcn_mfma_f32_32x32x16_bf16(t1.v[0][1], p3, S.o0, 0, 0, 0); S.o1 = __builtin_amdgcn_mfma_f32_32x32x16_bf16(t1.v[1][1], p3, S.o1, 0, 0, 0);
}
#define ATT_KEYREL(r, hi) (16 * ((r) >> 3) + 8 * (hi) + ((r) & 7))

__device__ __forceinline__ void glds16(const GAS void* gsrc, unsigned lds_dst) { unsigned keep;
    asm volatile("s_mov_b32 %0, m0\n\ts_mov_b32 m0, %2\n\ts_nop 0\n\tglobal_load_lds_dwordx4 %1, off\n\ts_mov_b32 m0, %0" : "=&s"(keep) : "v"(gsrc), "s"(lds_dst) : "memory"); }
__device__ __forceinline__ void pv8(St& S, const bf16x8 (&pp)[4], const bf16x8 (&vv)[8]) {
#pragma unroll
    for (int i = 0; i < 4; ++i) { const int sub = i >> 1, kc = i & 1;
        S.o0 = __builtin_amdgcn_mfma_f32_32x32x16_bf16(vv[4 * sub + kc], pp[i], S.o0, 0, 0, 0);
        S.o1 = __builtin_amdgcn_mfma_f32_32x32x16_bf16(vv[4 * sub + 2 + kc], pp[i], S.o1, 0, 0, 0); }
}
__device__ __forceinline__ void fox_unit3(int b, int h, int qb, const GAS bf16_t* __restrict__ QK, const GAS bf16_t* __restrict__ VT, GAS bf16_t* O, const LAS float* ncs, LAS unsigned char* ring, int wid, int lane) {
    const int r32 = lane & 31, hi = lane >> 5, q0 = 256 * qb + 32 * wid;
    const int kap = (r32 & 0x13) | ((r32 & 4) << 1) | ((r32 & 8) >> 1);
    const GAS bf16_t* Qp = QK + (size_t)(b * 4096 + q0 + r32) * 2048 + h * 64 + 8 * hi;
    bf16x8 qf[4];
#pragma unroll
    for (int d0 = 0; d0 < 4; ++d0) qf[d0] = *(const GAS bf16x8*)(Qp + 16 * d0);
    const GAS bf16_t* src; size_t kstep;
    if (wid < 4) { src = QK + (size_t)(b * 4096 + kap) * 2048 + 1024 + h * 64 + 8 * hi + 16 * wid; kstep = 2048; }
    else { const int f = wid - 4; src = VT + (size_t)(b * 1024 + h * 64 + 32 * (f >> 1) + r32) * 4096 + 8 * hi + 16 * (f & 1); kstep = 1; }
    const unsigned ldst = (unsigned)__builtin_amdgcn_readfirstlane((int)((unsigned)(uintptr_t)ring + (unsigned)wid * 1024u));
#define FX_DMA(T) do { const GAS bf16_t* s_ = src + (size_t)(64 * (T)) * kstep; const unsigned d_ = ldst + (unsigned)((T) & 3) * 16384u; glds16(s_, d_); glds16(s_ + 32 * kstep, d_ + 8192u); } while (0)
    const int nT = 4 * qb + 4, Tl = (8 * qb + wid) >> 1, qrow = 32 * wid + r32;
    St S; S.m = NEG; S.l = 0.f; S.o0 = f32x16{}; S.o1 = f32x16{};
    bf16x8 kf[8], vprev[8], pprev[4];
#pragma unroll
    for (int i = 0; i < 8; ++i) vprev[i] = bf16x8{};
#pragma unroll
    for (int i = 0; i < 4; ++i) pprev[i] = bf16x8{};
    FX_DMA(nT - 1); FX_DMA(nT - 2); FX_DMA(nT - 3);
    asm volatile("" :: "v"(qf[0]), "v"(qf[1]), "v"(qf[2]), "v"(qf[3]));
#define FX_RDK(T) do { const LAS unsigned char* fb = ring + ((T) & 3) * 16384 + lane * 16; \
        _Pragma("unroll") for (int i = 0; i < 8; ++i) kf[i] = *(const LAS bf16x8*)(fb + (i >> 2) * 8192 + (i & 3) * 1024); } while (0)
#define FX_RDC(T) do { const LAS f32x4* cp = (const LAS f32x4*)(ncs + 64 * (T) + 8 * hi); \
        const f32x4 a0 = cp[0], a1 = cp[1], a2 = cp[4], a3 = cp[5], b0 = cp[8], b1 = cp[9], b2 = cp[12], b3 = cp[13]; \
        _Pragma("unroll") for (int j = 0; j < 4; ++j) { c0[j] = a0[j]; c0[4 + j] = a1[j]; c0[8 + j] = a2[j]; c0[12 + j] = a3[j]; c1[j] = b0[j]; c1[4 + j] = b1[j]; c1[8 + j] = b2[j]; c1[12 + j] = b3[j]; } } while (0)
    f32x16 c0 = f32x16{}, c1 = f32x16{};
#define FX_RDV(T) do { const LAS unsigned char* fb = ring + ((T) & 3) * 16384 + 4096 + lane * 16; \
        _Pragma("unroll") for (int i = 0; i < 8; ++i) vprev[i] = *(const LAS bf16x8*)(fb + (i >> 2) * 8192 + (i & 3) * 1024); } while (0)
    for (int T = nT - 1; T >= 0; --T) {
        if (T >= 2) asm volatile("s_waitcnt vmcnt(2) lgkmcnt(0)" ::: "memory"); else asm volatile("s_waitcnt vmcnt(0) lgkmcnt(0)" ::: "memory");
        __builtin_amdgcn_s_barrier(); asm volatile("" ::: "memory");
        if (T >= 3) FX_DMA(T - 3);
        if (T <= Tl) {
            if (T == Tl) FX_RDK(T);
            FX_RDC(T);
            f32x16 s0 = c0, s1 = c1;
#pragma unroll
            for (int d0 = 0; d0 < 4; ++d0) { s0 = __builtin_amdgcn_mfma_f32_32x32x16_bf16(kf[d0], qf[d0], s0, 0, 0, 0); s1 = __builtin_amdgcn_mfma_f32_32x32x16_bf16(kf[4 + d0], qf[d0], s1, 0, 0, 0); }
            FX_RDK(T - 1);
            if (T == Tl) { const int kb = 64 * T - 256 * qb;
#pragma unroll
                for (int r = 0; r < 16; ++r) { if (kb + ATT_KEYREL(r, hi) > qrow) s0[r] = NEG; if (kb + 32 + ATT_KEYREL(r, hi) > qrow) s1[r] = NEG; } }
            pv8(S, pprev, vprev);
            FX_RDV(T);
            float ma = __builtin_fmaxf(__builtin_fmaxf(s0[0], s0[1]), s0[2]), mb = __builtin_fmaxf(__builtin_fmaxf(s1[0], s1[1]), s1[2]);
            ma = __builtin_fmaxf(ma, s0[3]); mb = __builtin_fmaxf(mb, s1[3]);
#pragma unroll
            for (int r = 4; r < 16; r += 2) { ma = __builtin_fmaxf(__builtin_fmaxf(ma, s0[r]), s0[r + 1]); mb = __builtin_fmaxf(__builtin_fmaxf(mb, s1[r]), s1[r + 1]); }
            float mx = __builtin_fmaxf(ma, mb); mx = __builtin_fmaxf(mx, __shfl_xor(mx, 32));
            const float mnew = __builtin_fmaxf(S.m, mx), alpha = __builtin_amdgcn_exp2f(S.m - mnew); S.m = mnew;
            s0 = s0 - mnew; s1 = s1 - mnew;
#pragma unroll
            for (int r = 0; r < 16; ++r) { s0[r] = __builtin_amdgcn_exp2f(s0[r]); s1[r] = __builtin_amdgcn_exp2f(s1[r]); }
            { const f32x16 t = s0 + s1; float pa = (t[0] + t[1]) + (t[2] + t[3]), pb = (t[4] + t[5]) + (t[6] + t[7]), pc = (t[8] + t[9]) + (t[10] + t[11]), pd = (t[12] + t[13]) + (t[14] + t[15]);
              S.l = S.l * alpha + ((pa + pb) + (pc + pd)); }
            if (__any(alpha != 1.0f)) { S.o0 *= alpha; S.o1 *= alpha; }
            u32x4 w0, w1, w2, w3;
            w0.x = cvtpk(s0[0], s0[1]); w0.y = cvtpk(s0[2], s0[3]); w0.z = cvtpk(s0[4], s0[5]); w0.w = cvtpk(s0[6], s0[7]);
            w1.x = cvtpk(s0[8], s0[9]); w1.y = cvtpk(s0[10], s0[11]); w1.z = cvtpk(s0[12], s0[13]); w1.w = cvtpk(s0[14], s0[15]);
            w2.x = cvtpk(s1[0], s1[1]); w2.y = cvtpk(s1[2], s1[3]); w2.z = cvtpk(s1[4], s1[5]); w2.w = cvtpk(s1[6], s1[7]);
            w3.x = cvtpk(s1[8], s1[9]); w3.y = cvtpk(s1[10], s1[11]); w3.z = cvtpk(s1[12], s1[13]); w3.w = cvtpk(s1[14], s1[15]);
            pprev[0] = __builtin_bit_cast(bf16x8, w0); pprev[1] = __builtin_bit_cast(bf16x8, w1); pprev[2] = __builtin_bit_cast(bf16x8, w2); pprev[3] = __builtin_bit_cast(bf16x8, w3);
        }
    }
    pv8(S, pprev, vprev);
#undef FX_DMA
#undef FX_RDK
#undef FX_RDV
#undef FX_RDC
    const float lt = S.l + __shfl_xor(S.l, 32); const float inv = __builtin_amdgcn_rcpf(lt);
    GAS bf16_t* Op = O + (size_t)(b * 4096 + q0 + r32) * 1024 + h * 64 + 4 * hi;
#pragma unroll
    for (int dh = 0; dh < 2; ++dh)
#pragma unroll
        for (int rg = 0; rg < 4; ++rg) { const f32x16& o = dh ? S.o1 : S.o0; u32x2 w; w.x = cvtpk(o[4 * rg] * inv, o[4 * rg + 1] * inv); w.y = cvtpk(o[4 * rg + 2] * inv, o[4 * rg + 3] * inv);
            *(GAS u32x2*)(Op + 32 * dh + 8 * rg) = w; }
    asm volatile("s_waitcnt lgkmcnt(0)" ::: "memory"); __builtin_amdgcn_s_barrier(); asm volatile("" ::: "memory");
}

__device__ __forceinline__ void attn0_phase(int g, int vcu, const GAS bf16_t* __restrict__ QK, const GAS bf16_t* __restrict__ VT, GAS bf16_t* O, GAS float* LSE, LAS unsigned char* ring, int wid, int lane) {
    const int r32 = lane & 31, hi = lane >> 5, lgd = 2 * g, lgL = 12 - lgd, TLm = (128 >> lgd) - 1;
    const int kap = (r32 & 0x13) | ((r32 & 4) << 1) | ((r32 & 8) >> 1);
    const unsigned ldst = (unsigned)__builtin_amdgcn_readfirstlane((int)((unsigned)(uintptr_t)ring + (unsigned)wid * 1024u));
    for (int su = vcu; su < 256; su += (int)gridDim.x) {
        const int bh = su >> 1, b = bh >> 4, h = bh & 15, half = su & 1;
        const GAS bf16_t* src; size_t tstep;
        if (wid < 4) { src = QK + (size_t)(b * 4096 + kap) * 2048 + 1024 + h * 64 + 8 * hi + 16 * wid; tstep = (size_t)32 * 2048; }
        else { const int f = wid - 4; src = VT + (size_t)(b * 1024 + h * 64 + 32 * (f >> 1) + r32) * 4096 + 8 * hi + 16 * (f & 1); tstep = 32; }
        for (int j = 0; j < 8; ++j) {
            const int rt0 = 64 * half + 8 * j, lt0 = rt0 & TLm;
            const int lo = (j == 0) ? ((lt0 == 0) ? rt0 : rt0 - 4) : rt0;
            asm volatile("s_waitcnt lgkmcnt(0)" ::: "memory"); __builtin_amdgcn_s_barrier(); asm volatile("" ::: "memory");
            for (int gt = lo; gt < rt0 + 8; ++gt) glds16(src + (size_t)gt * tstep, ldst + (unsigned)(gt & 15) * 8192u);
            const int rt = rt0 + wid, lt = lt0 + wid, kt0 = (lt >= 4) ? 0 : 4 - lt;
            const int w0 = rt * 32, c = w0 >> lgL, i0 = w0 & ((1 << lgL) - 1);
            const GAS bf16_t* Qp = QK + (size_t)(b * 4096 + w0 + r32) * 2048 + h * 64 + 8 * hi;
            bf16x8 qf[4];
#pragma unroll
            for (int d0 = 0; d0 < 4; ++d0) qf[d0] = *(const GAS bf16x8*)(Qp + 16 * d0);
            const int row = b * 4096 + ((i0 + r32) << lgd) + c;
            GAS bf16_t* Op = O + (size_t)row * 1024 + h * 64 + 4 * hi;
            u32x2 pv[8]; float lp = 0.f;
            if (g > 0) { lp = LSE[(size_t)row * 16 + h];
#pragma unroll
                for (int i = 0; i < 8; ++i) pv[i] = *(const GAS u32x2*)(Op + 32 * (i >> 2) + 8 * (i & 3)); }
            asm volatile("s_waitcnt vmcnt(0)" ::: "memory"); __builtin_amdgcn_s_barrier(); asm volatile("" ::: "memory");
            St S; S.m = NEG; S.l = 0.f; S.o0 = f32x16{}; S.o1 = f32x16{};
#define A0_LDT(KVv, gt_) do { const LAS unsigned char* fb = ring + ((gt_) & 15) * 8192 + lane * 16; \
                _Pragma("unroll") for (int d0 = 0; d0 < 4; ++d0) KVv.k[d0] = *(const LAS bf16x8*)(fb + d0 * 1024); \
                _Pragma("unroll") for (int f = 0; f < 4; ++f) KVv.v[f >> 1][f & 1] = *(const LAS bf16x8*)(fb + 4096 + f * 1024); } while (0)
            if (kt0 == 0) {
                KV ka, kb;
                A0_LDT(ka, rt - 4); A0_LDT(kb, rt - 3);
                { f32x16 st = qk(ka, qf);
#pragma unroll
                  for (int r = 0; r < 16; ++r) if (ATT_KEYREL(r, hi) < r32) st[r] = NEG;
                  upd(S, st, ka); }
                A0_LDT(ka, rt - 2);
                upd64(S, qk(kb, qf), qk(ka, qf), kb, ka);
                A0_LDT(kb, rt - 1); A0_LDT(ka, rt);
                { f32x16 s1 = qk(ka, qf);
#pragma unroll
                  for (int r = 0; r < 16; ++r) if (ATT_KEYREL(r, hi) > r32) s1[r] = NEG;
                  upd64(S, qk(kb, qf), s1, kb, ka); }
            } else {
                for (int kt = kt0; kt < 5; ++kt) { KV ka; A0_LDT(ka, rt - 4 + kt); f32x16 st = qk(ka, qf);
                    if (kt == 4) {
#pragma unroll
                        for (int r = 0; r < 16; ++r) if (ATT_KEYREL(r, hi) > r32) st[r] = NEG; }
                    upd(S, st, ka); }
            }
#undef A0_LDT
            const float lt_ = S.l + __shfl_xor(S.l, 32); float inv = __builtin_amdgcn_rcpf(lt_); float lse = S.m + __builtin_amdgcn_logf(lt_);
            float wprev = 0.f;
            if (g > 0) { const float mn = fmaxf(lp, lse), ea = __builtin_amdgcn_exp2f(lse - mn), eb = __builtin_amdgcn_exp2f(lp - mn), den = ea + eb, rd = __builtin_amdgcn_rcpf(den);
                inv *= ea * rd; wprev = eb * rd; lse = mn + __builtin_amdgcn_logf(den); }
#pragma unroll
            for (int dh = 0; dh < 2; ++dh)
#pragma unroll
                for (int rg = 0; rg < 4; ++rg) { const f32x16& o = dh ? S.o1 : S.o0; float v0 = o[4 * rg] * inv, v1 = o[4 * rg + 1] * inv, v2 = o[4 * rg + 2] * inv, v3 = o[4 * rg + 3] * inv;
                    if (g > 0) { const u32x2 p = pv[4 * dh + rg]; v0 += wprev * bflo(p.x); v1 += wprev * bfhi(p.x); v2 += wprev * bflo(p.y); v3 += wprev * bfhi(p.y); }
                    u32x2 w; w.x = cvtpk(v0, v1); w.y = cvtpk(v2, v3); *(GAS u32x2*)(Op + 32 * dh + 8 * rg) = w; }
            if (hi == 0) LSE[(size_t)row * 16 + h] = lse;
        }
    }
    asm volatile("s_waitcnt lgkmcnt(0)" ::: "memory"); __builtin_amdgcn_s_barrier(); asm volatile("" ::: "memory");
}
}

typedef unsigned short bf16;
typedef float f32x4 __attribute__((ext_vector_type(4)));
typedef unsigned v4u __attribute__((ext_vector_type(4)));
constexpr size_t MiB = 1u << 20;
constexpr size_t WS_ROT = 0, WS_RSP = 256 * 1024, WS_BAR = 768 * 1024, WS_SS = 1 * MiB, WS_LF = 9 * MiB, WS_LSE = 11 * MiB;
constexpr size_t WS_WTA = 16 * MiB, WS_WTAO = 34 * MiB, WS_WTB = 36 * MiB, WS_WTBV = 41 * MiB, WS_WTBO = 43 * MiB, WS_WTGU = 45 * MiB, WS_WTD = 67 * MiB;
constexpr size_t WS_XB = 80 * MiB, WS_O = 144 * MiB, WS_QK = 208 * MiB, WS_VT = 336 * MiB, WS_ACT = 208 * MiB, WS_END = 464 * MiB;
constexpr size_t SZ_WTGU = 11 * MiB, SZ_WTD = (size_t)1024 * 2816 * 2, SZ_SS = 2 * MiB;
constexpr int NWAVES = 8, LDS_BYTES = 147456;
constexpr int NPH = 16;

#define XB_TMO      128
#define XB_XCNT(j)  (256  + 64 * (j))
#define XB_CEN      3400
#define XB_XSUB(j)  (1280 + 64 * (j))
#define XB_XGEN(j)  (2304 + 64 * (j))
#define XB_TOP      3328
#define XB_TOPGEN   3392
#define XCD_BAR_WORDS 3456
#define XB_SPIN_CAP (1u << 18)

__device__ __forceinline__ unsigned xb_ld(unsigned* p)              { return __hip_atomic_load(p, __ATOMIC_RELAXED, __HIP_MEMORY_SCOPE_AGENT); }
__device__ __forceinline__ unsigned xb_add(unsigned* p, unsigned v) { return __hip_atomic_fetch_add(p, v, __ATOMIC_RELAXED, __HIP_MEMORY_SCOPE_AGENT); }
__device__ __forceinline__ unsigned xb_xcc_id() { return (unsigned)__builtin_amdgcn_s_getreg((3 << 11) | 20) & 0xFu; }
#define XB_SPIN(cond, bar) do { unsigned _sp = 0; while (cond) { __builtin_amdgcn_s_sleep(1); \
    if ((++_sp & 255u) == 0u) { if (xb_ld(&(bar)[XB_TMO])) break; if (_sp > XB_SPIN_CAP) { atomicAdd(&(bar)[XB_TMO], 1u); break; } } } } while (0)

struct XcdBarrier {
    unsigned* bar; unsigned x;
    volatile LAS unsigned* st;
};

__device__ __forceinline__ XcdBarrier xcd_barrier_post(unsigned* bar, volatile LAS unsigned* st) {
    XcdBarrier b; b.bar = bar; b.x = xb_xcc_id(); b.st = st;
    if (threadIdx.x == 0) (void)__hip_atomic_fetch_add((unsigned long long*)&bar[XB_CEN + 2 * (b.x >> 3)], 1ull << (8 * (b.x & 7)), __ATOMIC_RELAXED, __HIP_MEMORY_SCOPE_AGENT);
    return b;
}
__device__ __forceinline__ void xcd_barrier_complete(unsigned* bar, unsigned x, unsigned& nloc, unsigned& nx) {
    const unsigned G = gridDim.x * gridDim.y * gridDim.z;
    unsigned sum, cnt, mine, sp = 0u;
    for (;;) {
        sum = 0u; cnt = 0u; mine = 0u;
        const unsigned long long ca = __hip_atomic_load((unsigned long long*)&bar[XB_CEN], __ATOMIC_RELAXED, __HIP_MEMORY_SCOPE_AGENT), cb = __hip_atomic_load((unsigned long long*)&bar[XB_CEN + 2], __ATOMIC_RELAXED, __HIP_MEMORY_SCOPE_AGENT);
#pragma unroll
        for (unsigned j = 0; j < 16; ++j) { const unsigned c = (unsigned)(((j < 8u) ? (ca >> (8u * j)) : (cb >> (8u * (j - 8u)))) & 255ull); sum += c; cnt += (c > 0u) ? 1u : 0u; mine = (j == x) ? c : mine; }
        if (sum == G) break;
        __builtin_amdgcn_s_sleep(1);
        if ((++sp & 255u) == 0u) { if (xb_ld(&bar[XB_TMO])) break; if (sp > XB_SPIN_CAP) { atomicAdd(&bar[XB_TMO], 1u); break; } }
    }
    nloc = mine > 0u ? mine : 1u; nx = cnt > 0u ? cnt : 1u;
}

__device__ __forceinline__ void xcd_barrier(const XcdBarrier& b) {
    asm volatile("s_waitcnt vmcnt(0)" ::: "memory");
    __syncthreads();
    if (threadIdx.x == 0) {
        unsigned* bar = b.bar;
        __builtin_amdgcn_s_waitcnt(0);
        unsigned nloc = b.st[0], nx = b.st[1];
        if (nloc == 0u) { xcd_barrier_complete(bar, b.x, nloc, nx); b.st[0] = nloc; b.st[1] = nx; }
        const unsigned old = xb_add(&bar[XB_XSUB(b.x)], 1u);
        const unsigned gen = old / nloc;
        if (old + 1u == (gen + 1u) * nloc) {
            __builtin_amdgcn_fence(__ATOMIC_RELEASE, "agent");
            asm volatile("s_waitcnt vmcnt(0)" ::: "memory");
            const unsigned og = xb_add(&bar[XB_TOP], 1u);
            const unsigned tg = og / nx;
            if (og + 1u == (tg + 1u) * nx) xb_add(&bar[XB_TOPGEN], 1u);
            else XB_SPIN(xb_ld(&bar[XB_TOPGEN]) == tg, bar);
            __builtin_amdgcn_fence(__ATOMIC_ACQUIRE, "agent");
            xb_add(&bar[XB_XGEN(b.x)], 1u);
            asm volatile("s_waitcnt vmcnt(0)" ::: "memory");
        } else {
            XB_SPIN(xb_ld(&bar[XB_XGEN(b.x)]) == gen, bar);
            __builtin_amdgcn_fence(__ATOMIC_ACQUIRE, "agent");
            asm volatile("s_waitcnt vmcnt(0)" ::: "memory");
        }
    }
    __syncthreads();
}


struct Args {
    const float* x; const float* a_norm; const float* a_w_in; const float* a_w_out; const float* b_norm; const float* b_w_in; const float* b_f; const float* b_w_out;
    const float* ffn_norm; const float* ffn_w_gu; const float* ffn_w_down; const float* final_norm; float* out; unsigned char* ws; int ph_lo, ph_hi;
};

__device__ __forceinline__ unsigned f2bf(float f) { unsigned u = __builtin_bit_cast(unsigned, f); return (u + 0x7fffu + ((u >> 16) & 1u)) >> 16; }
__device__ __forceinline__ unsigned pk2(float lo, float hi) { return pg8::cvt_pk_bf16(lo, hi); }
__device__ __forceinline__ float wave_sum(float v) {
#pragma unroll
    for (int o = 1; o < 64; o <<= 1) v += __shfl_xor(v, o);
    return v;
}
__device__ __forceinline__ void transpose_item(const GAS float* __restrict__ W, int ldw, int k0, int nsrc0, const GAS float* __restrict__ gain, GAS bf16* WT, int Kd, int drow0, LAS float* scr, int lane) {
    float wv[32];
    const GAS float* wp = W + (size_t)(k0 + (lane >> 5)) * ldw + nsrc0 + (lane & 31);
#pragma unroll
    for (int i = 0; i < 32; ++i) wv[i] = wp[(size_t)(2 * i) * ldw];
    const int c = lane & 7;
    f32x4 g0 = {1.f, 1.f, 1.f, 1.f}, g1 = {1.f, 1.f, 1.f, 1.f};
    if (gain) { g0 = *(const GAS f32x4*)(gain + k0 + 8 * c); g1 = *(const GAS f32x4*)(gain + k0 + 8 * c + 4); }
    asm volatile("" :: "v"(wv[0]), "v"(wv[1]), "v"(wv[2]), "v"(wv[3]), "v"(wv[4]), "v"(wv[5]), "v"(wv[6]), "v"(wv[7]), "v"(wv[8]), "v"(wv[9]), "v"(wv[10]), "v"(wv[11]), "v"(wv[12]), "v"(wv[13]), "v"(wv[14]), "v"(wv[15]));
    asm volatile("" :: "v"(wv[16]), "v"(wv[17]), "v"(wv[18]), "v"(wv[19]), "v"(wv[20]), "v"(wv[21]), "v"(wv[22]), "v"(wv[23]), "v"(wv[24]), "v"(wv[25]), "v"(wv[26]), "v"(wv[27]), "v"(wv[28]), "v"(wv[29]), "v"(wv[30]), "v"(wv[31]));
#pragma unroll
    for (int i = 0; i < 32; ++i) scr[(2 * i + (lane >> 5)) * 33 + (lane & 31)] = wv[i];
    asm volatile("s_waitcnt lgkmcnt(0)" ::: "memory");
#pragma unroll
    for (int j = 0; j < 4; ++j) { const int n = (lane >> 3) + 8 * j; const LAS float* s = scr + (8 * c) * 33 + n;
        v4u o; o.x = pk2(s[0 * 33] * g0[0], s[1 * 33] * g0[1]); o.y = pk2(s[2 * 33] * g0[2], s[3 * 33] * g0[3]); o.z = pk2(s[4 * 33] * g1[0], s[5 * 33] * g1[1]); o.w = pk2(s[6 * 33] * g1[2], s[7 * 33] * g1[3]);
        *(GAS v4u*)(WT + (size_t)(drow0 + n) * Kd + k0 + 8 * c) = o; }
    asm volatile("s_waitcnt lgkmcnt(0)" ::: "memory");
}

__device__ __forceinline__ void prologue(const Args& a, GAS unsigned char* ws, int bid, LAS unsigned char* lds, int tid, int lane, int wave) {
    LAS float* scr = (LAS float*)(lds + wave * 16384);
    const int gw = bid * NWAVES + wave, NGW = gridDim.x * NWAVES;
    const int gt = bid * (NWAVES * 64) + tid, NGT = gridDim.x * NWAVES * 64;
    constexpr int I_A = 16 * 288, I_AO = 16 * 32, I_BQK = 16 * 64, I_BV = 16 * 32, I_BO = 16 * 32, I_GU = 16 * 176, I_D = 44 * 32;
    constexpr int NITEMS = I_A + I_AO + I_BQK + I_BV + I_BO + 2 * I_GU + 2 * I_D;
    for (int it = gw; it < NITEMS; it += NGW) {
        int r = it;
        if (r < I_A) { const int kb = r / 288, nb = r % 288; transpose_item((const GAS float*)a.a_w_in, 9216, 64 * kb, 32 * nb, (const GAS float*)a.a_norm, (GAS bf16*)(ws + WS_WTA), 1024, 32 * nb, scr, lane); continue; } r -= I_A;
        if (r < I_AO) { const int kb = r / 32, nb = r % 32; transpose_item((const GAS float*)a.a_w_out, 1024, 64 * kb, 32 * nb, nullptr, (GAS bf16*)(ws + WS_WTAO), 1024, 32 * nb, scr, lane); continue; } r -= I_AO;
        if (r < I_BQK) { const int kb = r / 64, nb = r % 64; transpose_item((const GAS float*)a.b_w_in, 3088, 64 * kb, 32 * nb, (const GAS float*)a.b_norm, (GAS bf16*)(ws + WS_WTB), 1024, 32 * nb, scr, lane); continue; } r -= I_BQK;
        if (r < I_BV) { const int kb = r / 32, nb = r % 32; transpose_item((const GAS float*)a.b_w_in, 3088, 64 * kb, 2048 + 32 * nb, (const GAS float*)a.b_norm, (GAS bf16*)(ws + WS_WTBV), 1024, 32 * nb, scr, lane); continue; } r -= I_BV;
        if (r < I_BO) { const int kb = r / 32, nb = r % 32; transpose_item((const GAS float*)a.b_w_out, 1024, 64 * kb, 32 * nb, nullptr, (GAS bf16*)(ws + WS_WTBO), 1024, 32 * nb, scr, lane); continue; } r -= I_BO;
        if (r < 2 * I_GU) { const int l = r / I_GU, q = r % I_GU, kb = q / 176, nb = q % 176, n0 = 32 * nb;
            const int drow = (n0 < FF) ? (256 * (n0 / 128) + (n0 % 128)) : (256 * ((n0 - FF) / 128) + 128 + ((n0 - FF) % 128));
            transpose_item((const GAS float*)a.ffn_w_gu + (size_t)l * 1024 * 5632, 5632, 64 * kb, n0, (const GAS float*)a.ffn_norm + l * 1024, (GAS bf16*)(ws + WS_WTGU + l * SZ_WTGU), 1024, drow, scr, lane); continue; } r -= 2 * I_GU;
        { const int l = r / I_D, q = r % I_D, kb = q / 32, nb = q % 32;
            transpose_item((const GAS float*)a.ffn_w_down + (size_t)l * 2816 * 1024, 1024, 64 * kb, 32 * nb, nullptr, (GAS bf16*)(ws + WS_WTD + l * SZ_WTD), 2816, 32 * nb, scr, lane); }
    }
    { GAS bf16* wtb = (GAS bf16*)(ws + WS_WTB);
      for (int i = gt; i < 16 * 1024; i += NGT) { const int col = i >> 10, k = i & 1023; wtb[(size_t)(2048 + col) * 1024 + k] = (bf16)f2bf(((const GAS float*)a.b_w_in)[(size_t)k * 3088 + 3072 + col] * ((const GAS float*)a.b_norm)[k]); }
      GAS v4u* z = (GAS v4u*)(wtb + (size_t)2064 * 1024); for (int i = gt; i < 240 * 1024 / 8; i += NGT) z[i] = (v4u){0u, 0u, 0u, 0u}; }
    { GAS float* rot = (GAS float*)(ws + WS_ROT);
      for (int i = gt; i < 4096 * 8; i += NGT) { const int s = i >> 3, d = i & 7; const float invf = exp2f(-(float)d * 0.125f * 18.931568569324174f);
          const float ang = (float)s * invf; const float k = rintf(ang * 0.15915494309189535f); float rr = fmaf(-k, 6.28125f, ang); rr = fmaf(-k, 0.0019353071795864769f, rr);
          rot[2 * i] = __builtin_amdgcn_cosf(rr * 0.15915494309189535f); rot[2 * i + 1] = __builtin_amdgcn_sinf(rr * 0.15915494309189535f); } }
    { GAS bf16* xb = (GAS bf16*)(ws + WS_XB); GAS float* rsp = (GAS float*)(ws + WS_RSP);
      for (int row0 = gw * 4; row0 < MT; row0 += NGW * 4) {
          f32x4 v[4][4]; float sq[4];
#pragma unroll
          for (int q = 0; q < 4; ++q) { const GAS f32x4* xr = (const GAS f32x4*)((const GAS float*)a.x + (size_t)(row0 + q) * 1024) + lane;
#pragma unroll
              for (int j = 0; j < 4; ++j) v[q][j] = xr[64 * j]; }
#pragma unroll
          for (int q = 0; q < 4; ++q) { float s = 0.f;
#pragma unroll
              for (int j = 0; j < 4; ++j) s += (v[q][j][0] * v[q][j][0] + v[q][j][1] * v[q][j][1]) + (v[q][j][2] * v[q][j][2] + v[q][j][3] * v[q][j][3]);
              sq[q] = s; }
#pragma unroll
          for (int o = 1; o < 64; o <<= 1) {
#pragma unroll
              for (int q = 0; q < 4; ++q) sq[q] += __shfl_xor(sq[q], o); }
#pragma unroll
          for (int q = 0; q < 4; ++q) { const int row = row0 + q; const float r = 1.0f / sqrtf(sq[q] * (1.0f / 1024.0f) + RMS_EPS);
              GAS unsigned long long* o8 = (GAS unsigned long long*)(xb + (size_t)row * 1024) + lane;
#pragma unroll
              for (int j = 0; j < 4; ++j) o8[64 * j] = (unsigned long long)pk2(v[q][j][0], v[q][j][1]) | ((unsigned long long)pk2(v[q][j][2], v[q][j][3]) << 32);
              if (lane < 3) { const int lgd = 2 * lane, lgL = 12 - lgd, b = row >> 12, s_ = row & 4095; rsp[(size_t)lane * MT + b * 4096 + ((s_ & ((1 << lgd) - 1)) << lgL) + (s_ >> lgd)] = r; } }
      } }
}

__device__ __forceinline__ void final_norm_phase(const GAS float* fnorm, GAS float* outp, int bid, const GAS bf16* hb, const GAS float* ss, int lane, int wave) {
    const int gw = bid * NWAVES + wave, NGW = gridDim.x * NWAVES;
    f32x4 gn[4];
#pragma unroll
    for (int j = 0; j < 4; ++j) gn[j] = ((const GAS f32x4*)fnorm)[lane + 64 * j];
    for (int row0 = gw * 4; row0 < MT; row0 += NGW * 4) {
        unsigned long long w[4][4]; float r[4];
#pragma unroll
        for (int q = 0; q < 4; ++q) { const GAS unsigned long long* h8 = (const GAS unsigned long long*)(hb + (size_t)(row0 + q) * 1024) + lane;
#pragma unroll
            for (int j = 0; j < 4; ++j) w[q][j] = h8[64 * j]; }
#pragma unroll
        for (int q = 0; q < 4; ++q) { const GAS f32x4* p = (const GAS f32x4*)(ss + (size_t)(row0 + q) * 16); const f32x4 s0 = p[0], s1 = p[1], s2 = p[2], s3 = p[3];
            const float t = ((s0[0] + s0[1]) + (s0[2] + s0[3])) + ((s1[0] + s1[1]) + (s1[2] + s1[3])) + ((s2[0] + s2[1]) + (s2[2] + s2[3])) + ((s3[0] + s3[1]) + (s3[2] + s3[3]));
            r[q] = 1.0f / sqrtf(t * (1.0f / 1024.0f) + RMS_EPS); }
#pragma unroll
        for (int q = 0; q < 4; ++q) { GAS f32x4* o = (GAS f32x4*)(outp + (size_t)(row0 + q) * 1024) + lane;
#pragma unroll
            for (int j = 0; j < 4; ++j) { const unsigned lo = (unsigned)w[q][j], hi = (unsigned)(w[q][j] >> 32);
                const f32x4 v = (f32x4){__uint_as_float(lo << 16), __uint_as_float(lo & 0xffff0000u), __uint_as_float(hi << 16), __uint_as_float(hi & 0xffff0000u)};
                o[64 * j] = v * r[q] * gn[j]; } }
    }
}


__device__ __forceinline__ void fgate_pass(const GAS bf16* hb, const GAS bf16* wf, const GAS float* ss, const GAS float* bf, GAS float* lf, int bid, int wave, int lane) {
    typedef short bf16x8v __attribute__((ext_vector_type(8)));
    const int fr = lane & 15, fq = lane >> 4;
    for (int rb = bid * NWAVES + wave; rb < MT / 16; rb += (int)gridDim.x * NWAVES) {
        const int row = rb * 16 + fr;
        const GAS bf16* ap = hb + (size_t)row * 1024 + 8 * fq; const GAS bf16* bp = wf + (size_t)fr * 1024 + 8 * fq;
        const GAS f32x4* sp = (const GAS f32x4*)(ss + (size_t)row * 16); const f32x4 s0 = sp[0], s1 = sp[1], s2 = sp[2], s3 = sp[3];
        f32x4 acc = {0.f, 0.f, 0.f, 0.f};
#pragma unroll
        for (int kb = 0; kb < 2; ++kb) {
            bf16x8v af[16], wf16[16];
#pragma unroll
            for (int k = 0; k < 16; ++k) { af[k] = *(const GAS bf16x8v*)(ap + 32 * (16 * kb + k)); wf16[k] = *(const GAS bf16x8v*)(bp + 32 * (16 * kb + k)); }
            asm volatile("" :: "v"(af[15]), "v"(wf16[15]));
#pragma unroll
            for (int k = 0; k < 16; ++k) acc = __builtin_amdgcn_mfma_f32_16x16x32_bf16(wf16[k], af[k], acc, 0, 0, 0); }
        const float t = ((s0[0] + s0[1]) + (s0[2] + s0[3])) + ((s1[0] + s1[1]) + (s1[2] + s1[3])) + ((s2[0] + s2[1]) + (s2[2] + s2[3])) + ((s3[0] + s3[1]) + (s3[2] + s3[3]));
        const float r = __builtin_amdgcn_rsqf(t * (1.0f / 1024.0f) + RMS_EPS);
        const f32x4 bv = *(const GAS f32x4*)(bf + 4 * fq); f32x4 o;
#pragma unroll
        for (int j = 0; j < 4; ++j) { const float x = acc[j] * r + bv[j]; const float e = __builtin_amdgcn_exp2f(-fabsf(x) * LOG2E); o[j] = fminf(x, 0.f) * LOG2E - __builtin_amdgcn_logf(1.0f + e); }
        *(GAS f32x4*)(lf + (size_t)row * 16 + 4 * fq) = o;
    }
}

template <class Epi> __device__ __forceinline__ void run_gemm(int tid, int bid, LAS unsigned char* lds, const GAS bf16* A, const GAS bf16* Bt, int Mr, int N, int K, int adil, int bdil, const Epi& E) {
    pg8::Gemm g{A, Bt, Mr, N, K, adil, bdil}; pg8::StaticOrder S; S.init(Mr, N, (int)gridDim.x, bid);
    pg8::gemm_phase<Epi, pg8::StaticOrder, true, true>(lds, g, S, E, tid);
}

#ifndef PHMASK
#define PHMASK 0xffff
#endif
#define PHON(k) (((PHMASK) >> (k)) & 1)
__device__ __forceinline__ unsigned long long stash_ld(LAS unsigned char* lds, int i) { const LAS unsigned* p = (const LAS unsigned*)(lds + 147456 - 128) + 2 * i; const unsigned lo = p[0], hi = p[1];
    return ((unsigned long long)(unsigned)__builtin_amdgcn_readfirstlane((int)hi) << 32) | (unsigned)__builtin_amdgcn_readfirstlane((int)lo); }
__global__ void __launch_bounds__(NWAVES * 64, 2) mega_fwd(Args a) {
    extern __shared__ __attribute__((aligned(16))) unsigned char lds_raw[];
    LAS unsigned char* lds = (LAS unsigned char*)lds_raw;
    cg::grid_group grid = cg::this_grid();

    volatile LAS unsigned* bst = (volatile LAS unsigned*)(lds + 147456 - 64);
    if (threadIdx.x < 2) bst[threadIdx.x] = 0u;
    if (threadIdx.x == 0) { LAS unsigned long long* stash = (LAS unsigned long long*)(lds + 147456 - 128);
        stash[0] = (unsigned long long)(uintptr_t)a.x; stash[1] = (unsigned long long)(uintptr_t)a.b_f; stash[2] = (unsigned long long)(uintptr_t)a.final_norm; stash[3] = (unsigned long long)(uintptr_t)a.out; }
    __syncthreads();
    XcdBarrier xbar = xcd_barrier_post((unsigned*)(a.ws + WS_BAR), bst);
    if (a.ph_hi == -12345) grid.sync();
    {
        int tid = threadIdx.x; asm volatile("" : "+v"(tid));
        const int lane = tid & 63, wave = __builtin_amdgcn_readfirstlane(tid >> 6);
        prologue(a, (GAS unsigned char*)a.ws, (int)blockIdx.x, lds, tid, lane, wave);
        xcd_barrier(xbar);
    }
    for (int ph = (a.ph_lo > 1 ? a.ph_lo : 1); ph < a.ph_hi; ++ph) {
#ifdef REPMASK
        for (int rep = 0; rep < 1 + ((REPMASK >> ph) & 1); ++rep)
#endif
        {
        int tid = threadIdx.x; asm volatile("" : "+v"(tid));
        const int lane = tid & 63, wave = __builtin_amdgcn_readfirstlane(tid >> 6);
        int bid = blockIdx.x; asm volatile("" : "+s"(bid));
        unsigned char* ws0 = a.ws; asm volatile("" : "+s"(ws0));
        GAS unsigned char* ws = (GAS unsigned char*)ws0;
        GAS bf16* XB = (GAS bf16*)(ws + WS_XB); GAS bf16* OB = (GAS bf16*)(ws + WS_O); GAS bf16* QK = (GAS bf16*)(ws + WS_QK); GAS bf16* VT = (GAS bf16*)(ws + WS_VT); GAS bf16* ACT = (GAS bf16*)(ws + WS_ACT);
        GAS float* LSE = (GAS float*)(ws + WS_LSE); GAS float* LF = (GAS float*)(ws + WS_LF);
        if (PHON(1) && (ph == 1 || ph == 2 || ph == 4 || ph == 6)) {
            const int ga = (ph - 2) >> 1, gq = (ph == 1) ? 0 : ga + 1;
            if (ph != 1) { GAS bf16* qk = (ga & 1) ? (GAS bf16*)stash_ld(lds, 3) : QK; GAS bf16* vt = (ga & 1) ? (GAS bf16*)(ws + 400 * MiB) : VT;
                const int G = gridDim.x; const int v = (G % 8 == 0) ? (int)((bid % 8) * (G / 8) + bid / 8) : bid; att::attn0_phase(ga, v, qk, vt, OB, LSE, lds, wave, lane); }
            if (gq < 3) { GAS bf16* qk = (gq & 1) ? (GAS bf16*)stash_ld(lds, 3) : QK; GAS bf16* vt = (gq & 1) ? (GAS bf16*)(ws + 400 * MiB) : VT;
                const int dil = 1 << (2 * gq); const GAS bf16* wt = (const GAS bf16*)(ws + WS_WTA) + (size_t)gq * 3072 * 1024; const GAS float* rsp = (const GAS float*)(ws + WS_RSP) + (size_t)gq * MT;
                { pg8::EpiQK0 E{qk, rsp, (const GAS float*)(ws + WS_ROT), 2 * gq}; run_gemm(tid, bid, lds, XB, wt, MT, 2048, 1024, dil, 1, E); }
                { pg8::EpiVT E{vt, rsp, nullptr}; run_gemm(tid, bid, lds, wt + (size_t)2048 * 1024, XB, 1024, MT, 1024, 1, dil, E); } }
        } else if (PHON(7) && (ph == 7 || ph == 12)) {
            const int l = (ph == 12); const GAS bf16* wt = (const GAS bf16*)(ws + (l ? WS_WTBO : WS_WTAO));
            pg8::EpiRes E{l ? (const GAS float*)nullptr : (const GAS float*)stash_ld(lds, 0), XB, (GAS float*)(ws + WS_SS + (size_t)(2 * l) * SZ_SS)}; run_gemm(tid, bid, lds, OB, wt, MT, 1024, 1024, 1, 1, E);
        } else if (PHON(8) && (ph == 8 || ph == 13)) {
            const int l = (ph == 13); pg8::EpiSwiglu E{ACT, (const GAS float*)(ws + WS_SS + (size_t)(2 * l) * SZ_SS)};
            run_gemm(tid, bid, lds, XB, (const GAS bf16*)(ws + WS_WTGU + l * SZ_WTGU), MT, 5632, 1024, 1, 1, E);
        } else if (PHON(9) && (ph == 9 || ph == 14)) {
            const int l = (ph == 14); pg8::EpiRes E{(const GAS float*)nullptr, XB, (GAS float*)(ws + WS_SS + (size_t)(2 * l + 1) * SZ_SS)};
            run_gemm(tid, bid, lds, ACT, (const GAS bf16*)(ws + WS_WTD + l * SZ_WTD), MT, 1024, 2816, 1, 1, E);
        } else if (PHON(10) && ph == 10) {
            const GAS float* ss = (const GAS float*)(ws + WS_SS + SZ_SS);
            fgate_pass(XB, (const GAS bf16*)(ws + WS_WTB) + (size_t)2048 * 1024, ss, (const GAS float*)stash_ld(lds, 1), LF, bid, wave, lane);
            { pg8::EpiQKB E{QK, ss, (const GAS float*)stash_ld(lds, 1), LF}; run_gemm(tid, bid, lds, XB, (const GAS bf16*)(ws + WS_WTB), MT, 2048, 1024, 1, 1, E); }
            { pg8::EpiVT E{VT, nullptr, ss}; run_gemm(tid, bid, lds, (const GAS bf16*)(ws + WS_WTBV), XB, 1024, MT, 1024, 1, 1, E); }
        } else if (PHON(11) && ph == 11) {
            const int G = gridDim.x; const int v = (G % 8 == 0) ? (int)((bid % 8) * (G / 8) + bid / 8) : bid;
            LAS float* cs = (LAS float*)lds; LAS float* wsum = cs + 4096;
            for (int su = v; su < 256; su += G) {
                const int bh = su >> 1, b = bh >> 4, h = bh & 15, set = su & 1;
                __syncthreads();
                float vl[8]; const GAS float* lp = LF + (size_t)(b * 4096 + 8 * tid) * 16 + h;
#pragma unroll
                for (int i = 0; i < 8; ++i) vl[i] = lp[i * 16];
#pragma unroll
                for (int i = 1; i < 8; ++i) vl[i] += vl[i - 1];
                float xs = vl[7];
#pragma unroll
                for (int o = 1; o < 64; o <<= 1) { const float t = __shfl_up(xs, o); if (lane >= o) xs += t; }
                if (lane == 63) wsum[wave] = xs;
                __syncthreads();
                float off = xs - vl[7];
                for (int w = 0; w < wave; ++w) off += wsum[w];
#pragma unroll
                for (int i = 0; i < 8; ++i) cs[8 * tid + i] = -(vl[i] + off);
                __syncthreads();
                for (int ui = 0; ui < 8; ++ui) { const int k = ui >> 1; const int qb = (ui & 1) ? (15 - 2 * k - set) : (2 * k + set); att::fox_unit3(b, h, qb, QK, VT, OB, cs, lds + 32768, wave, lane); }
            }
        } else if (PHON(15) && ph == 15) {
            final_norm_phase((const GAS float*)stash_ld(lds, 2), (GAS float*)stash_ld(lds, 3), bid, XB, (const GAS float*)(ws + WS_SS + 3 * SZ_SS), lane, wave);
        }
        }
        if (ph + 1 < a.ph_hi && ph != 3 && ph != 5) xcd_barrier(xbar);
    }
}

#ifndef MK_N_LAUNCHES
#define MK_N_LAUNCHES 1
#endif
extern "C" void kernel_launch(void* const* d_in, const int* in_sizes, int n_in, void* d_out, int out_size, void* d_ws, size_t ws_size, hipStream_t stream) {
    static int grid = 0;
    if (grid == 0) {
        if (n_in != 12 || out_size != MT * DM || ws_size < WS_END) { fprintf(stderr, "kernel_launch: unexpected problem (n_in %d out %d ws %zu)\n", n_in, out_size, ws_size); grid = -1; return; }
        int dev = 0, cus = 0, per_cu = 0;
        (void)hipGetDevice(&dev); (void)hipDeviceGetAttribute(&cus, hipDeviceAttributeMultiprocessorCount, dev);
        (void)hipFuncSetAttribute((const void*)mega_fwd, hipFuncAttributeMaxDynamicSharedMemorySize, LDS_BYTES);
        if (hipOccupancyMaxActiveBlocksPerMultiprocessor(&per_cu, (const void*)mega_fwd, NWAVES * 64, LDS_BYTES) != hipSuccess || per_cu < 1) per_cu = 1;
        (void)hipGetLastError();
        grid = cus * per_cu; if (grid <= 0) grid = 256;
    }
    if (grid < 0) return;
    (void)hipMemsetAsync((unsigned char*)d_ws + WS_BAR, 0, XCD_BAR_WORDS * sizeof(unsigned), stream);
    Args a{};
    a.x = (const float*)d_in[0]; a.a_norm = (const float*)d_in[1]; a.a_w_in = (const float*)d_in[2]; a.a_w_out = (const float*)d_in[3]; a.b_norm = (const float*)d_in[4]; a.b_w_in = (const float*)d_in[5];
    a.b_f = (const float*)d_in[6]; a.b_w_out = (const float*)d_in[7]; a.ffn_norm = (const float*)d_in[8]; a.ffn_w_gu = (const float*)d_in[9]; a.ffn_w_down = (const float*)d_in[10]; a.final_norm = (const float*)d_in[11];
    a.out = (float*)d_out; a.ws = (unsigned char*)d_ws;
#if MK_N_LAUNCHES == 1
    a.ph_lo = 0; a.ph_hi = NPH; void* args[] = {&a};
    hipError_t e = hipLaunchCooperativeKernel((const void*)mega_fwd, dim3(grid), dim3(NWAVES * 64), args, LDS_BYTES, stream);
    if (e != hipSuccess) fprintf(stderr, "cooperative launch failed: %s (grid %d)\n", hipGetErrorString(e), grid);
#else
    for (int p = 0; p < NPH; ++p) { a.ph_lo = p; a.ph_hi = p + 1; hipLaunchKernelGGL(mega_fwd, dim3(grid), dim3(NWAVES * 64), LDS_BYTES, stream, a); }
#endif
}
```

```cpp
#include <hip/hip_runtime.h>
#include <hip/hip_cooperative_groups.h>
#include <cstdio>
#include <cstdint>
namespace cg = cooperative_groups;

constexpr int NB = 8, SEQ = 4096, DM = 1024, MT = NB * SEQ, NH = 16, HD = 64, FF = 2816;
constexpr float RMS_EPS = 1e-6f;
constexpr float LOG2E = 1.4426950408889634f;
constexpr float QSCALE = 0.125f * LOG2E;
#define LAS __attribute__((address_space(3)))
#define GAS __attribute__((address_space(1)))

namespace pg8 {
#define PG8_LAS __attribute__((address_space(3)))
typedef unsigned short bf16_t;
typedef short bf16x8 __attribute__((ext_vector_type(8)));
typedef float f32x4 __attribute__((ext_vector_type(4)));
typedef unsigned u32x4 __attribute__((ext_vector_type(4)));
constexpr int BM = 256, BK = 64, HALF = 128, HTB = HALF * BK * 2  , STAGE_BYTES = 8 * HTB, NXCD = 8, WGM = 8;

__host__ __device__ __forceinline__ int lds_byte(int r, int c) { const int st = (r >> 4) * 2 + (c >> 5), rr = r & 15, cc = c & 31, ob = rr * 64 + cc * 2; return st * 1024 + (ob ^ (((ob >> 9) & 1) << 5)); }
__host__ __device__ __forceinline__ void stage_rc(int b, int& R, int& C) { const int st = b / 1024, sb = b % 1024, swz = sb ^ (((sb >> 9) & 1) << 5); R = (st >> 1) * 16 + swz / 64; C = (st & 1) * 32 + (swz % 64) / 2; }
__host__ __device__ __forceinline__ int perm32(int rho) { const int n = rho >> 4, i = rho & 15; return 8 * (i >> 2) + 4 * n + (i & 3); }

struct Unit { int pm, pn; };
struct Gemm { const GAS bf16_t* A; const GAS bf16_t* Bt; int M, N, K, adil, bdil; };
__device__ __forceinline__ int perm_tile_row(int tile, int dil) { const int rho0 = tile * 256, b = rho0 >> 12, w = rho0 & 4095, L = 4096 / dil, c = w / L, i0 = w % L; return b * 4096 + i0 * dil + c; }

struct StaticOrder {
    int nM, nN, nwg, G, c;
    __host__ __device__ void init(int M, int N, int G_, int c_) { nM = M / BM; nN = N / BM; nwg = nM * nN; G = G_; c = c_; }
    __host__ __device__ bool next(int i, Unit& u) const {
        const long L = (long)i * G + c; if (L >= nwg) return false;
        int wgid = (int)L; { const int q = nwg / NXCD, r = nwg % NXCD, xcd = wgid % NXCD, off = wgid / NXCD; wgid = (xcd < r ? xcd * (q + 1) : r * (q + 1) + (xcd - r) * q) + off; }
        const int nig = WGM * nN, gid = wgid / nig, fm = gid * WGM, gsz = (nM - fm) < WGM ? (nM - fm) : WGM;
        u.pm = fm + ((wgid % nig) % gsz); u.pn = (wgid % nig) / gsz; return true;
    }
    __device__ __forceinline__ void a_ready(const Unit&) const {}
    __device__ __forceinline__ void done(const Unit&) const {}
};

typedef float f32x2 __attribute__((ext_vector_type(2))); typedef __bf16 bf16x2v __attribute__((ext_vector_type(2)));
__device__ __forceinline__ unsigned cvt_pk_bf16(float lo, float hi) { const f32x2 v = {lo, hi}; const bf16x2v b = __builtin_convertvector(v, bf16x2v); return __builtin_bit_cast(unsigned, b); }
typedef unsigned u32x2 __attribute__((ext_vector_type(2)));
__device__ __forceinline__ u32x4 pack8(const f32x4 a, const f32x4 b) { u32x4 w; w.x = cvt_pk_bf16(a[0], a[1]); w.y = cvt_pk_bf16(a[2], a[3]); w.z = cvt_pk_bf16(b[0], b[1]); w.w = cvt_pk_bf16(b[2], b[3]); return w; }
__device__ __forceinline__ float row_rs(const GAS float* ss, int row, int fq) {
    const f32x4 p = *(const GAS f32x4*)(ss + (size_t)row * 16 + 4 * fq); float t = (p[0] + p[1]) + (p[2] + p[3]);
    t += __shfl_xor(t, 16); t += __shfl_xor(t, 32); return __builtin_amdgcn_rsqf(t * (1.0f / 1024.0f) + 1e-6f);
}

__device__ __forceinline__ float fq_sum(float t) {
    auto a = __builtin_amdgcn_permlane16_swap(__float_as_uint(t), __float_as_uint(t), false, false); t = __uint_as_float(a[0]) + __uint_as_float(a[1]);
    auto b = __builtin_amdgcn_permlane32_swap(__float_as_uint(t), __float_as_uint(t), false, false); return __uint_as_float(b[0]) + __uint_as_float(b[1]);
}
__device__ __forceinline__ void rows_rs8(const GAS float* ss, int row0  , int fq, float (&rr)[2][4]) {
    f32x4 p[2][4];
#pragma unroll
    for (int ai = 0; ai < 2; ++ai)
#pragma unroll
        for (int m = 0; m < 4; ++m) p[ai][m] = *(const GAS f32x4*)(ss + (size_t)(row0 + ai * HALF + m * 16) * 16 + 4 * fq);
    asm volatile("" :: "v"(p[0][0]), "v"(p[0][1]), "v"(p[0][2]), "v"(p[0][3]), "v"(p[1][0]), "v"(p[1][1]), "v"(p[1][2]), "v"(p[1][3]));
#pragma unroll
    for (int ai = 0; ai < 2; ++ai)
#pragma unroll
        for (int m = 0; m < 4; ++m) { float t = (p[ai][m][0] + p[ai][m][1]) + (p[ai][m][2] + p[ai][m][3]);
            t = fq_sum(t); rr[ai][m] = __builtin_amdgcn_rsqf(t * (1.0f / 1024.0f) + 1e-6f); }
}

struct EpiQK0 {
    static constexpr bool PERM = true, AFTER_DRAIN = false;
    GAS bf16_t* out; const GAS float* rsp; const GAS float* rot; int lgd;
    __device__ __forceinline__ void operator()(const f32x4 (&acc)[2][2][4][2], const Unit& u, int wr, int wc, int fr, int fq) const {
        const int col0 = u.pn * BM + wc * 32 + 8 * fq; const bool rotw = (wc & 1) == 0; const float qs = (u.pn < 4) ? 0.125f * 1.4426950408889634f : 1.0f;
        const int lgL = 12 - lgd, Lm = (1 << lgL) - 1; const float sgn = (fq == 0) ? -1.0f : 1.0f; const bool rl = fq < 2;
        float rr[2][4];
#pragma unroll
        for (int ai = 0; ai < 2; ++ai)
#pragma unroll
            for (int m = 0; m < 4; ++m) rr[ai][m] = rsp[u.pm * BM + ai * HALF + wr * 64 + m * 16 + fr];
        asm volatile("" :: "v"(rr[0][0]), "v"(rr[0][1]), "v"(rr[0][2]), "v"(rr[0][3]), "v"(rr[1][0]), "v"(rr[1][1]), "v"(rr[1][2]), "v"(rr[1][3]));
#pragma unroll
        for (int ai = 0; ai < 2; ++ai)
#pragma unroll
            for (int m = 0; m < 4; ++m) rr[ai][m] *= qs;
#pragma unroll
        for (int ai = 0; ai < 2; ++ai)
#pragma unroll
            for (int mp = 0; mp < 2; ++mp) {
                f32x4 cs[2][4];
                if (rotw) {
#pragma unroll
                    for (int mm = 0; mm < 2; ++mm) { const int rho = u.pm * BM + ai * HALF + wr * 64 + (2 * mp + mm) * 16 + fr, w = rho & 4095, s = ((w & Lm) << lgd) + (w >> lgL);
                        const GAS f32x4* tp = (const GAS f32x4*)(rot + (size_t)s * 16);
#pragma unroll
                        for (int i = 0; i < 4; ++i) cs[mm][i] = tp[i]; }
                    asm volatile("" :: "v"(cs[0][0]), "v"(cs[0][1]), "v"(cs[0][2]), "v"(cs[0][3]), "v"(cs[1][0]), "v"(cs[1][1]), "v"(cs[1][2]), "v"(cs[1][3])); }
#pragma unroll
                for (int mm = 0; mm < 2; ++mm) { const int m = 2 * mp + mm;
                    const int rho = u.pm * BM + ai * HALF + wr * 64 + m * 16 + fr; const float r = rr[ai][m];
#pragma unroll
                    for (int bj = 0; bj < 2; ++bj) { f32x4 v[2];
#pragma unroll
                        for (int n = 0; n < 2; ++n) { v[n] = acc[ai][bj][m][n] * r;
                            if (rotw) { const f32x4 ca = cs[mm][2 * n], cb = cs[mm][2 * n + 1]; f32x4 p;
#pragma unroll
                                for (int j = 0; j < 4; ++j) p[j] = __shfl_xor(v[n][j], 16);
                                if (rl) { v[n][0] = v[n][0] * ca[0] + sgn * p[0] * ca[1]; v[n][1] = v[n][1] * ca[2] + sgn * p[1] * ca[3];
                                          v[n][2] = v[n][2] * cb[0] + sgn * p[2] * cb[1]; v[n][3] = v[n][3] * cb[2] + sgn * p[3] * cb[3]; } } }
                        *(GAS u32x4*)(out + (size_t)rho * 2048 + col0 + bj * HALF) = pack8(v[0], v[1]); }
                }
            }
    }
};
struct EpiVT {
    static constexpr bool PERM = true, AFTER_DRAIN = false;
    GAS bf16_t* vt; const GAS float* rsp; const GAS float* ss;
    __device__ __forceinline__ void operator()(const f32x4 (&acc)[2][2][4][2], const Unit& u, int wr, int wc, int fr, int fq) const {
        const int rho0 = u.pn * BM + wc * 32 + 8 * fq; float rt = 0.f;
        if (!rsp) {
            const int tok = rho0 + (fr >> 3) * HALF + (fr & 7); const GAS f32x4* p = (const GAS f32x4*)(ss + (size_t)tok * 16);
            const f32x4 a = p[0], b = p[1], c = p[2], d = p[3];
            const float t = ((a[0] + a[1]) + (a[2] + a[3])) + ((b[0] + b[1]) + (b[2] + b[3])) + ((c[0] + c[1]) + (c[2] + c[3])) + ((d[0] + d[1]) + (d[2] + d[3]));
            rt = __builtin_amdgcn_rsqf(t * (1.0f / 1024.0f) + 1e-6f); }
        const int b = rho0 >> 12, w = rho0 & 4095, lb = (fq << 4);
#pragma unroll
        for (int bj = 0; bj < 2; ++bj) { float sc[8];
            if (rsp) { const f32x4 a = *(const GAS f32x4*)(rsp + rho0 + bj * HALF), b2 = *(const GAS f32x4*)(rsp + rho0 + bj * HALF + 4);
#pragma unroll
                for (int j = 0; j < 4; ++j) { sc[j] = a[j]; sc[4 + j] = b2[j]; } }
            else {
#pragma unroll
                for (int k = 0; k < 8; ++k) sc[k] = __shfl(rt, lb + bj * 8 + k); }
#pragma unroll
            for (int ai = 0; ai < 2; ++ai)
#pragma unroll
                for (int m = 0; m < 4; ++m) { const int f = u.pm * BM + ai * HALF + wr * 64 + m * 16 + fr; GAS bf16_t* rowp = vt + ((size_t)(b * 1024 + f)) * 4096 + w;
                    f32x4 v0 = acc[ai][bj][m][0], v1 = acc[ai][bj][m][1];
#pragma unroll
                    for (int j = 0; j < 4; ++j) { v0[j] *= sc[j]; v1[j] *= sc[4 + j]; }
                    *(GAS u32x4*)(rowp + bj * HALF) = pack8(v0, v1); } }
    }
};
struct EpiRes {
    static constexpr bool PERM = true, AFTER_DRAIN = false;
    const GAS float* resf; GAS bf16_t* hb; GAS float* ss;
    __device__ __forceinline__ void operator()(const f32x4 (&acc)[2][2][4][2], const Unit& u, int wr, int wc, int fr, int fq) const {
        const int col0 = u.pn * BM + wc * 32 + 8 * fq;
#pragma unroll
        for (int ai = 0; ai < 2; ++ai) {
            f32x4 r0[4][2], r1[4][2];
            if (resf) {
#pragma unroll
                for (int m = 0; m < 4; ++m)
#pragma unroll
                    for (int bj = 0; bj < 2; ++bj) { const size_t off = (size_t)(u.pm * BM + ai * HALF + wr * 64 + m * 16 + fr) * 1024 + col0 + bj * HALF;
                        r0[m][bj] = *(const GAS f32x4*)(resf + off); r1[m][bj] = *(const GAS f32x4*)(resf + off + 4); }
            } else { u32x4 w[4][2];
#pragma unroll
                for (int m = 0; m < 4; ++m)
#pragma unroll
                    for (int bj = 0; bj < 2; ++bj) w[m][bj] = *(const GAS u32x4*)(hb + (size_t)(u.pm * BM + ai * HALF + wr * 64 + m * 16 + fr) * 1024 + col0 + bj * HALF);
                asm volatile("" :: "v"(w[0][0]), "v"(w[0][1]), "v"(w[1][0]), "v"(w[1][1]), "v"(w[2][0]), "v"(w[2][1]), "v"(w[3][0]), "v"(w[3][1]));
#pragma unroll
                for (int m = 0; m < 4; ++m)
#pragma unroll
                    for (int bj = 0; bj < 2; ++bj) { const u32x4 x = w[m][bj];
                        r0[m][bj] = (f32x4){__uint_as_float(x.x << 16), __uint_as_float(x.x & 0xffff0000u), __uint_as_float(x.y << 16), __uint_as_float(x.y & 0xffff0000u)};
                        r1[m][bj] = (f32x4){__uint_as_float(x.z << 16), __uint_as_float(x.z & 0xffff0000u), __uint_as_float(x.w << 16), __uint_as_float(x.w & 0xffff0000u)}; } }
#pragma unroll
            for (int m = 0; m < 4; ++m) { const int row = u.pm * BM + ai * HALF + wr * 64 + m * 16 + fr; float q = 0.f;
#pragma unroll
                for (int bj = 0; bj < 2; ++bj) { const size_t off = (size_t)row * 1024 + col0 + bj * HALF;
                    const f32x4 v0 = acc[ai][bj][m][0] + r0[m][bj], v1 = acc[ai][bj][m][1] + r1[m][bj];
                    q += (v0[0] * v0[0] + v0[1] * v0[1]) + (v0[2] * v0[2] + v0[3] * v0[3]) + (v1[0] * v1[0] + v1[1] * v1[1]) + (v1[2] * v1[2] + v1[3] * v1[3]);
                    *(GAS u32x4*)(hb + off) = pack8(v0, v1); }
                q = fq_sum(q);
                if (fq == 0) ss[(size_t)row * 16 + u.pn * 4 + wc] = q; }
        }
    }
};
struct EpiSwiglu {
    static constexpr bool PERM = true, AFTER_DRAIN = false;
    GAS bf16_t* act; const GAS float* ss;
    __device__ __forceinline__ void operator()(const f32x4 (&acc)[2][2][4][2], const Unit& u, int wr, int wc, int fr, int fq) const {
        const int col0 = u.pn * HALF + wc * 32 + 8 * fq; float rr[2][4];
        rows_rs8(ss, u.pm * BM + wr * 64 + fr, fq, rr);
#pragma unroll
        for (int ai = 0; ai < 2; ++ai)
#pragma unroll
            for (int m = 0; m < 4; ++m) { const int row = u.pm * BM + ai * HALF + wr * 64 + m * 16 + fr; const float r = rr[ai][m];
                f32x4 o[2];
#pragma unroll
                for (int n = 0; n < 2; ++n) { const f32x4 gg = acc[ai][0][m][n] * r, uu = acc[ai][1][m][n] * r;
#pragma unroll
                    for (int j = 0; j < 4; ++j) { const float e = __builtin_amdgcn_exp2f(gg[j] * -1.4426950408889634f); o[n][j] = gg[j] * uu[j] * __builtin_amdgcn_rcpf(1.0f + e); } }
                *(GAS u32x4*)(act + (size_t)row * 2816 + col0) = pack8(o[0], o[1]); }
    }
};
struct EpiQKB {
    static constexpr bool PERM = true, AFTER_DRAIN = false;
    GAS bf16_t* out; const GAS float* ss; const GAS float* bf; GAS float* lf;
    __device__ __forceinline__ void operator()(const f32x4 (&acc)[2][2][4][2], const Unit& u, int wr, int wc, int fr, int fq) const {
        const int col0 = u.pn * BM + wc * 32 + 8 * fq; const float qs = (u.pn < 4) ? 0.125f * 1.4426950408889634f : 1.0f; float rr[2][4];
        rows_rs8(ss, u.pm * BM + wr * 64 + fr, fq, rr);
#pragma unroll
        for (int ai = 0; ai < 2; ++ai)
#pragma unroll
            for (int m = 0; m < 4; ++m) { const int row = u.pm * BM + ai * HALF + wr * 64 + m * 16 + fr; const float r0 = rr[ai][m], r = r0 * qs;
                if (u.pn < 8) {
#pragma unroll
                    for (int bj = 0; bj < 2; ++bj) *(GAS u32x4*)(out + (size_t)row * 2048 + col0 + bj * HALF) = pack8(acc[ai][bj][m][0] * r, acc[ai][bj][m][1] * r);
                } else if (wc == 0 && fq < 2) {
                    f32x4 o[2];
#pragma unroll
                    for (int n = 0; n < 2; ++n)
#pragma unroll
                        for (int j = 0; j < 4; ++j) { const float x = acc[ai][0][m][n][j] * r0 + bf[8 * fq + 4 * n + j];
                            const float e = __builtin_amdgcn_exp2f(-fabsf(x) * 1.4426950408889634f); o[n][j] = fminf(x, 0.f) * 1.4426950408889634f - __builtin_amdgcn_logf(1.0f + e); }
                    *(GAS f32x4*)(lf + (size_t)row * 16 + 8 * fq) = o[0]; *(GAS f32x4*)(lf + (size_t)row * 16 + 8 * fq + 4) = o[1];
                } }
    }
};

template <class Epi, class Sched, bool ALIGN_EPI = false, bool SP2 = false>
__device__ __forceinline__ void gemm_phase(PG8_LAS unsigned char* lds, const Gemm g, const Sched& S, const Epi& E, const int tid) {
    const int wid = __builtin_amdgcn_readfirstlane(tid >> 6), lane = tid & 63, wr = wid >> 2, wc = wid & 3, fr = lane & 15, fq = lane >> 4;
    const int K = g.K, nt = K / BK;
    unsigned voffA[2], voffB[2];
#pragma unroll
    for (int i = 0; i < 2; ++i) { int R, C; stage_rc(tid * 16 + i * 8192, R, C); const int Rb = Epi::PERM ? ((R & ~31) + perm32(R & 31)) : R;
        voffA[i] = (unsigned)(R * g.adil * K + C) * 2u; voffB[i] = (unsigned)(Rb * g.bdil * K + C) * 2u; }
    const size_t kstep = (size_t)(BK * 2);
    const size_t hstepA = (size_t)HALF * g.adil * K * 2, hstepB = (size_t)HALF * g.bdil * K * 2;
    const unsigned ldsw = (unsigned)wid * 1024u;
    const int aoff = lds_byte(wr * 64 + fr, fq * 8), boff = lds_byte(wc * 32 + fr, fq * 8);
#define PG8_SA(b, h) (((b) * 2 + (h)) * HTB)
#define PG8_SB(b, h) ((4 + (b) * 2 + (h)) * HTB)
#define PG8_STAGE(bufoff, gbase, voff) do { _Pragma("unroll") for (int _i = 0; _i < 2; ++_i) \
        __builtin_amdgcn_global_load_lds((const GAS unsigned*)((const GAS char*)(gbase) + (voff)[_i]), (PG8_LAS unsigned*)(lds + (bufoff) + ldsw + _i * 8192), 16, 0, 0); } while (0)
#define PG8_LDA(dst, b, h) do { _Pragma("unroll") for (int m = 0; m < 4; ++m) _Pragma("unroll") for (int k = 0; k < 2; ++k) dst[m][k] = *(const PG8_LAS bf16x8*)(lds + PG8_SA(b, h) + aoff + m * 2048 + k * 1024); } while (0)
#define PG8_LDB(dst, b, h) do { _Pragma("unroll") for (int n = 0; n < 2; ++n) _Pragma("unroll") for (int k = 0; k < 2; ++k) dst[n][k] = *(const PG8_LAS bf16x8*)(lds + PG8_SB(b, h) + boff + n * 2048 + k * 1024); } while (0)
#define PG8_MMA(ai, bj, At, Bt) do { __builtin_amdgcn_s_setprio(1); _Pragma("unroll") for (int m = 0; m < 4; ++m) _Pragma("unroll") for (int n = 0; n < 2; ++n) _Pragma("unroll") for (int k = 0; k < 2; ++k) \
        acc[ai][bj][m][n] = __builtin_amdgcn_mfma_f32_16x16x32_bf16(Bt[n][k], At[m][k], acc[ai][bj][m][n], 0, 0, 0); __builtin_amdgcn_s_setprio(0); } while (0)
#define PG8_WAIT_V(n) asm volatile("s_waitcnt vmcnt(" #n ")" ::: "memory")
#define PG8_WAIT_L(n) asm volatile("s_waitcnt lgkmcnt(" #n ")" ::: "memory")
#define PG8_BAR __builtin_amdgcn_s_barrier()
#define PG8_SCHED __builtin_amdgcn_sched_barrier(0)
    Unit cur, nxt; int ui = 0;
    if (!S.next(0, cur)) return;
    f32x4 acc[2][2][4][2];
#pragma unroll
    for (int a = 0; a < 2; ++a)
#pragma unroll
        for (int b = 0; b < 2; ++b)
#pragma unroll
            for (int m = 0; m < 4; ++m)
#pragma unroll
                for (int n = 0; n < 2; ++n) acc[a][b][m][n] = (f32x4){0.f, 0.f, 0.f, 0.f};
    bf16x8 At[4][2], B0[2][2], B1[2][2];
    const GAS char* cA = (const GAS char*)g.A + (size_t)perm_tile_row(cur.pm, g.adil) * K * 2; const GAS char* cB = (const GAS char*)g.Bt + (size_t)perm_tile_row(cur.pn, g.bdil) * K * 2;
    S.a_ready(cur);
    if constexpr (SP2) {
        PG8_STAGE(PG8_SB(0, 0), cB, voffB); PG8_STAGE(PG8_SB(0, 1), cB + hstepB, voffB); PG8_STAGE(PG8_SA(0, 0), cA, voffA); PG8_STAGE(PG8_SA(0, 1), cA + hstepA, voffA);
        if (wr == 1) PG8_BAR;
        PG8_WAIT_V(2); PG8_BAR;
        PG8_STAGE(PG8_SB(1, 0), cB + kstep, voffB); PG8_STAGE(PG8_SA(1, 0), cA + kstep, voffA); PG8_STAGE(PG8_SB(1, 1), cB + hstepB + kstep, voffB);
        PG8_WAIT_V(6); PG8_BAR;
    } else {
        PG8_STAGE(PG8_SB(0, 0), cB, voffB); PG8_STAGE(PG8_SA(0, 0), cA, voffA); PG8_STAGE(PG8_SB(0, 1), cB + hstepB, voffB); PG8_STAGE(PG8_SA(0, 1), cA + hstepA, voffA);
        if (wr == 1) PG8_BAR;
        PG8_WAIT_V(4); PG8_BAR;
        PG8_STAGE(PG8_SB(1, 0), cB + kstep, voffB); PG8_STAGE(PG8_SA(1, 0), cA + kstep, voffA); PG8_STAGE(PG8_SB(1, 1), cB + hstepB + kstep, voffB);
        PG8_WAIT_V(6); PG8_BAR;
    }
    for (;;) {
        const bool has_next = S.next(ui + 1, nxt);
        const GAS char* nA = has_next ? (const GAS char*)g.A + (size_t)perm_tile_row(nxt.pm, g.adil) * K * 2 : cA; const GAS char* nB = has_next ? (const GAS char*)g.Bt + (size_t)perm_tile_row(nxt.pn, g.bdil) * K * 2 : cB;
        for (int t = 0; t < nt; t += 2) {
            const bool last = (t == nt - 2);
            const GAS char* a1 = cA + (size_t)(t + 1) * kstep;
            const GAS char* a2 = last ? nA : cA + (size_t)(t + 2) * kstep; const GAS char* b2 = last ? nB : cB + (size_t)(t + 2) * kstep;
            const GAS char* a3 = a2 + kstep; const GAS char* b3 = b2 + kstep;
            if (last && has_next) S.a_ready(nxt);
            if constexpr (SP2) {
            PG8_LDB(B0, 0, 0); PG8_LDB(B1, 0, 1); PG8_SCHED; PG8_LDA(At, 0, 0); PG8_STAGE(PG8_SA(1, 1), a1 + hstepA, voffA);
            PG8_WAIT_V(8); PG8_WAIT_L(0); PG8_BAR; PG8_MMA(0, 0, At, B0); PG8_MMA(0, 1, At, B1); PG8_BAR; PG8_SCHED;
            PG8_LDA(At, 0, 1); PG8_STAGE(PG8_SB(0, 0), b2, voffB); PG8_STAGE(PG8_SB(0, 1), b2 + hstepB, voffB); PG8_STAGE(PG8_SA(0, 0), a2, voffA);
            PG8_WAIT_V(8); PG8_WAIT_L(0); PG8_BAR; PG8_MMA(1, 0, At, B0); PG8_MMA(1, 1, At, B1); PG8_BAR; PG8_SCHED;
            PG8_LDB(B0, 1, 0); PG8_LDB(B1, 1, 1); PG8_SCHED; PG8_LDA(At, 1, 0); PG8_STAGE(PG8_SA(0, 1), a2 + hstepA, voffA);
            PG8_WAIT_V(8); PG8_WAIT_L(0); PG8_BAR; PG8_MMA(0, 0, At, B0); PG8_MMA(0, 1, At, B1); PG8_BAR; PG8_SCHED;
            PG8_LDA(At, 1, 1); PG8_STAGE(PG8_SB(1, 0), b3, voffB); PG8_STAGE(PG8_SB(1, 1), b3 + hstepB, voffB); PG8_STAGE(PG8_SA(1, 0), a3, voffA);
            PG8_WAIT_V(8); PG8_WAIT_L(0); PG8_BAR; PG8_MMA(1, 0, At, B0); PG8_MMA(1, 1, At, B1); PG8_BAR; PG8_SCHED;
            } else {
            PG8_LDB(B0, 0, 0); PG8_SCHED; PG8_LDA(At, 0, 0); PG8_STAGE(PG8_SA(1, 1), a1 + hstepA, voffA);
            PG8_WAIT_L(8); PG8_BAR; PG8_WAIT_L(0); PG8_MMA(0, 0, At, B0); PG8_BAR; PG8_SCHED;
            PG8_LDB(B1, 0, 1); PG8_STAGE(PG8_SB(0, 0), b2, voffB);
            PG8_BAR; PG8_WAIT_L(0); PG8_MMA(0, 1, At, B1); PG8_BAR;
            PG8_LDA(At, 0, 1); PG8_STAGE(PG8_SA(0, 0), a2, voffA);
            PG8_BAR; PG8_WAIT_L(0); PG8_MMA(1, 0, At, B0); PG8_BAR; PG8_SCHED;
            PG8_STAGE(PG8_SB(0, 1), b2 + hstepB, voffB);
            PG8_WAIT_V(6); PG8_BAR; PG8_MMA(1, 1, At, B1); PG8_BAR;
            PG8_LDB(B0, 1, 0); PG8_SCHED; PG8_LDA(At, 1, 0); PG8_STAGE(PG8_SA(0, 1), a2 + hstepA, voffA);
            PG8_WAIT_L(8); PG8_BAR; PG8_WAIT_L(0); PG8_MMA(0, 0, At, B0); PG8_BAR; PG8_SCHED;
            PG8_LDB(B1, 1, 1); PG8_STAGE(PG8_SB(1, 0), b3, voffB);
            PG8_BAR; PG8_WAIT_L(0); PG8_MMA(0, 1, At, B1); PG8_BAR;
            PG8_LDA(At, 1, 1); PG8_STAGE(PG8_SA(1, 0), a3, voffA);
            PG8_BAR; PG8_WAIT_L(0); PG8_MMA(1, 0, At, B0); PG8_BAR; PG8_SCHED;
            PG8_STAGE(PG8_SB(1, 1), b3 + hstepB, voffB);
            PG8_WAIT_V(6); PG8_BAR; PG8_MMA(1, 1, At, B1); PG8_BAR;
            }
        }
        if constexpr (ALIGN_EPI) { if (wr == 0) PG8_BAR; }
        if constexpr (!Epi::AFTER_DRAIN) { E(acc, cur, wr, wc, fr, fq); S.done(cur); }
        if (!has_next) break;
#pragma unroll
        for (int a = 0; a < 2; ++a)
#pragma unroll
            for (int b = 0; b < 2; ++b)
#pragma unroll
                for (int m = 0; m < 4; ++m)
#pragma unroll
                    for (int n = 0; n < 2; ++n) acc[a][b][m][n] = (f32x4){0.f, 0.f, 0.f, 0.f};
        cur = nxt; cA = nA; cB = nB; ++ui;
        if constexpr (ALIGN_EPI) { if (wr == 1) PG8_BAR; }
    }
    PG8_WAIT_V(0);
    if constexpr (!ALIGN_EPI) { if (wr == 0) PG8_BAR; }
    PG8_BAR;
    if constexpr (Epi::AFTER_DRAIN) { E.fused(acc, cur, wr, wc, fr, fq, lds, wid, lane); S.done(cur); }
#undef PG8_SA
#undef PG8_SB
#undef PG8_STAGE
#undef PG8_LDA
#undef PG8_LDB
#undef PG8_MMA
#undef PG8_WAIT_V
#undef PG8_WAIT_L
#undef PG8_BAR
#undef PG8_SCHED
}
}

namespace att {
typedef unsigned short bf16_t;
typedef short bf16x8 __attribute__((ext_vector_type(8)));
typedef float f32x16 __attribute__((ext_vector_type(16)));
typedef float f32x4 __attribute__((ext_vector_type(4)));
typedef unsigned u32x2 __attribute__((ext_vector_type(2)));
typedef unsigned u32x4 __attribute__((ext_vector_type(4)));
typedef float f32x2_t __attribute__((ext_vector_type(2))); typedef __bf16 bf16x2_t __attribute__((ext_vector_type(2)));
__device__ __forceinline__ unsigned cvtpk(float lo, float hi) { f32x2_t v = {lo, hi}; bf16x2_t b = __builtin_convertvector(v, bf16x2_t); return __builtin_bit_cast(unsigned, b); }
__device__ __forceinline__ float bflo(unsigned w) { return __uint_as_float(w << 16); }
__device__ __forceinline__ float bfhi(unsigned w) { return __uint_as_float(w & 0xffff0000u); }
constexpr float NEG = -1e30f;

struct KV { bf16x8 k[4]; bf16x8 v[2][2]; };
__device__ __forceinline__ void load_kv(KV& t, const GAS bf16_t* Kp, const GAS bf16_t* Vp, int key0) {
#pragma unroll
    for (int d0 = 0; d0 < 4; ++d0) t.k[d0] = *(const GAS bf16x8*)(Kp + (size_t)key0 * 2048 + 16 * d0);
#pragma unroll
    for (int dh = 0; dh < 2; ++dh)
#pragma unroll
        for (int kc = 0; kc < 2; ++kc) t.v[dh][kc] = *(const GAS bf16x8*)(Vp + (size_t)dh * 32 * 4096 + key0 + 16 * kc);
}
struct St { float m, l; f32x16 o0, o1; };
__device__ __forceinline__ f32x16 qk(const KV& t, const bf16x8 (&qf)[4], f32x16 s = f32x16{}) {
#pragma unroll
    for (int d0 = 0; d0 < 4; ++d0) s = __builtin_amdgcn_mfma_f32_32x32x16_bf16(t.k[d0], qf[d0], s, 0, 0, 0);
    return s;
}
__device__ __forceinline__ void upd(St& S, f32x16 st, const KV& t) {
    float mx = fmaxf(fmaxf(st[0], st[1]), fmaxf(st[2], st[3]));
#pragma unroll
    for (int r = 4; r < 16; r += 4) mx = fmaxf(mx, fmaxf(fmaxf(st[r], st[r + 1]), fmaxf(st[r + 2], st[r + 3])));
    mx = fmaxf(mx, __shfl_xor(mx, 32));
    const float mnew = fmaxf(S.m, mx), alpha = __builtin_amdgcn_exp2f(S.m - mnew); S.m = mnew;
    float ps = 0.f;
#pragma unroll
    for (int r = 0; r < 16; ++r) { st[r] = __builtin_amdgcn_exp2f(st[r] - mnew); ps += st[r]; }
    S.l = S.l * alpha + ps;
    if (__any(alpha != 1.0f)) { S.o0 *= alpha; S.o1 *= alpha; }
    u32x4 w0, w1;
    w0.x = cvtpk(st[0], st[1]); w0.y = cvtpk(st[2], st[3]); w0.z = cvtpk(st[4], st[5]); w0.w = cvtpk(st[6], st[7]);
    w1.x = cvtpk(st[8], st[9]); w1.y = cvtpk(st[10], st[11]); w1.z = cvtpk(st[12], st[13]); w1.w = cvtpk(st[14], st[15]);
    const bf16x8 p0 = __builtin_bit_cast(bf16x8, w0), p1 = __builtin_bit_cast(bf16x8, w1);
    S.o0 = __builtin_amdgcn_mfma_f32_32x32x16_bf16(t.v[0][0], p0, S.o0, 0, 0, 0); S.o0 = __builtin_amdgcn_mfma_f32_32x32x16_bf16(t.v[0][1], p1, S.o0, 0, 0, 0);
    S.o1 = __builtin_amdgcn_mfma_f32_32x32x16_bf16(t.v[1][0], p0, S.o1, 0, 0, 0); S.o1 = __builtin_amdgcn_mfma_f32_32x32x16_bf16(t.v[1][1], p1, S.o1, 0, 0, 0);
}
__device__ __forceinline__ void upd64(St& S, f32x16 s0, f32x16 s1, const KV& t0, const KV& t1) {
    float mx = fmaxf(fmaxf(s0[0], s0[1]), fmaxf(s1[0], s1[1]));
#pragma unroll
    for (int r = 2; r < 16; r += 2) mx = fmaxf(mx, fmaxf(fmaxf(s0[r], s0[r + 1]), fmaxf(s1[r], s1[r + 1])));
    mx = fmaxf(mx, __shfl_xor(mx, 32));
    const float mnew = fmaxf(S.m, mx), alpha = __builtin_amdgcn_exp2f(S.m - mnew); S.m = mnew;
    s0 = s0 - mnew; s1 = s1 - mnew;
    float pa = 0.f, pb = 0.f;
#pragma unroll
    for (int r = 0; r < 16; ++r) { s0[r] = __builtin_amdgcn_exp2f(s0[r]); s1[r] = __builtin_amdgcn_exp2f(s1[r]); pa += s0[r]; pb += s1[r]; }
    S.l = S.l * alpha + (pa + pb);
    if (__any(alpha != 1.0f)) { S.o0 *= alpha; S.o1 *= alpha; }
    u32x4 w0, w1, w2, w3;
    w0.x = cvtpk(s0[0], s0[1]); w0.y = cvtpk(s0[2], s0[3]); w0.z = cvtpk(s0[4], s0[5]); w0.w = cvtpk(s0[6], s0[7]);
    w1.x = cvtpk(s0[8], s0[9]); w1.y = cvtpk(s0[10], s0[11]); w1.z = cvtpk(s0[12], s0[13]); w1.w = cvtpk(s0[14], s0[15]);
    w2.x = cvtpk(s1[0], s1[1]); w2.y = cvtpk(s1[2], s1[3]); w2.z = cvtpk(s1[4], s1[5]); w2.w = cvtpk(s1[6], s1[7]);
    w3.x = cvtpk(s1[8], s1[9]); w3.y = cvtpk(s1[10], s1[11]); w3.z = cvtpk(s1[12], s1[13]); w3.w = cvtpk(s1[14], s1[15]);
    const bf16x8 p0 = __builtin_bit_cast(bf16x8, w0), p1 = __builtin_bit_cast(bf16x8, w1), p2 = __builtin_bit_cast(bf16x8, w2), p3 = __builtin_bit_cast(bf16x8, w3);
    S.o0 = __builtin_amdgcn_mfma_f32_32x32x16_bf16(t0.v[0][0], p0, S.o0, 0, 0, 0); S.o1 = __builtin_amdgcn_mfma_f32_32x32x16_bf16(t0.v[1][0], p0, S.o1, 0, 0, 0);
    S.o0 = __builtin_amdgcn_mfma_f32_32x32x16_bf16(t0.v[0][1], p1, S.o0, 0, 0, 0); S.o1 = __builtin_amdgcn_mfma_f32_32x32x16_bf16(t0.v[1][1], p1, S.o1, 0, 0, 0);
    S.o0 = __builtin_amdgcn_mfma_f32_32x32x16_bf16(t1.v[0][0], p2, S.o0, 0, 0, 0); S.o1 = __builtin_amdgcn_mfma_f32_32x32x16_bf16(t1.v[1][0], p2, S.o1, 0, 0, 0);
    S.o0 = __builtin_amdgcn_mfma_f32_32x32x16_bf16(t1.v[0][1], p3, S.o0, 0, 0, 0); S.o1 = __builtin_amdgcn_mfma_f32_32x32x16_bf16(t1.v[1][1], p3, S.o1, 0, 0, 0);
}
#define ATT_KEYREL(r, hi) (16 * ((r) >> 3) + 8 * (hi) + ((r) & 7))

__device__ __forceinline__ void glds16(const GAS void* gsrc, unsigned lds_dst) { unsigned keep;
    asm volatile("s_mov_b32 %0, m0\n\ts_mov_b32 m0, %2\n\ts_nop 0\n\tglobal_load_lds_dwordx4 %1, off\n\ts_mov_b32 m0, %0" : "=&s"(keep) : "v"(gsrc), "s"(lds_dst) : "memory"); }
__device__ __forceinline__ void pv8(St& S, const bf16x8 (&pp)[4], const bf16x8 (&vv)[8]) {
#pragma unroll
    for (int i = 0; i < 4; ++i) { const int sub = i >> 1, kc = i & 1;
        S.o0 = __builtin_amdgcn_mfma_f32_32x32x16_bf16(vv[4 * sub + kc], pp[i], S.o0, 0, 0, 0);
        S.o1 = __builtin_amdgcn_mfma_f32_32x32x16_bf16(vv[4 * sub + 2 + kc], pp[i], S.o1, 0, 0, 0); }
}
__device__ __forceinline__ void fox_unit3(int b, int h, int qb, const GAS bf16_t* __restrict__ QK, const GAS bf16_t* __restrict__ VT, GAS bf16_t* O, const LAS float* ncs, LAS unsigned char* ring, int wid, int lane) {
    const int r32 = lane & 31, hi = lane >> 5, q0 = 256 * qb + 32 * wid;
    const int kap = (r32 & 0x13) | ((r32 & 4) << 1) | ((r32 & 8) >> 1);
    const GAS bf16_t* Qp = QK + (size_t)(b * 4096 + q0 + r32) * 2048 + h * 64 + 8 * hi;
    bf16x8 qf[4];
#pragma unroll
    for (int d0 = 0; d0 < 4; ++d0) qf[d0] = *(const GAS bf16x8*)(Qp + 16 * d0);
    const GAS bf16_t* src; size_t kstep;
    if (wid < 4) { src = QK + (size_t)(b * 4096 + kap) * 2048 + 1024 + h * 64 + 8 * hi + 16 * wid; kstep = 2048; }
    else { const int f = wid - 4; src = VT + (size_t)(b * 1024 + h * 64 + 32 * (f >> 1) + r32) * 4096 + 8 * hi + 16 * (f & 1); kstep = 1; }
    const unsigned ldst = (unsigned)__builtin_amdgcn_readfirstlane((int)((unsigned)(uintptr_t)ring + (unsigned)wid * 1024u));
#define FX_DMA(T) do { const GAS bf16_t* s_ = src + (size_t)(64 * (T)) * kstep; const unsigned d_ = ldst + (unsigned)((T) & 3) * 16384u; glds16(s_, d_); glds16(s_ + 32 * kstep, d_ + 8192u); } while (0)
    const int nT = 4 * qb + 4, Tl = (8 * qb + wid) >> 1, qrow = 32 * wid + r32;
    St S; S.m = NEG; S.l = 0.f; S.o0 = f32x16{}; S.o1 = f32x16{};
    bf16x8 kf[8], vprev[8], pprev[4];
#pragma unroll
    for (int i = 0; i < 8; ++i) vprev[i] = bf16x8{};
#pragma unroll
    for (int i = 0; i < 4; ++i) pprev[i] = bf16x8{};
    if (wid >= 4) __builtin_amdgcn_s_setprio(1);
    FX_DMA(nT - 1); FX_DMA(nT - 2); FX_DMA(nT - 3);
    asm volatile("" :: "v"(qf[0]), "v"(qf[1]), "v"(qf[2]), "v"(qf[3]));
#define FX_RDK(T) do { const LAS unsigned char* fb = ring + ((T) & 3) * 16384 + lane * 16; \
        _Pragma("unroll") for (int i = 0; i < 8; ++i) kf[i] = *(const LAS bf16x8*)(fb + (i >> 2) * 8192 + (i & 3) * 1024); } while (0)
#define FX_RDC(T) do { const LAS f32x4* cp = (const LAS f32x4*)(ncs + 64 * (T) + 8 * hi); \
        const f32x4 a0 = cp[0], a1 = cp[1], a2 = cp[4], a3 = cp[5], b0 = cp[8], b1 = cp[9], b2 = cp[12], b3 = cp[13]; \
        _Pragma("unroll") for (int j = 0; j < 4; ++j) { c0[j] = a0[j]; c0[4 + j] = a1[j]; c0[8 + j] = a2[j]; c0[12 + j] = a3[j]; c1[j] = b0[j]; c1[4 + j] = b1[j]; c1[8 + j] = b2[j]; c1[12 + j] = b3[j]; } } while (0)
    f32x16 c0 = f32x16{}, c1 = f32x16{};
#define FX_RDV(T) do { const LAS unsigned char* fb = ring + ((T) & 3) * 16384 + 4096 + lane * 16; \
        _Pragma("unroll") for (int i = 0; i < 8; ++i) vprev[i] = *(const LAS bf16x8*)(fb + (i >> 2) * 8192 + (i & 3) * 1024); } while (0)
    for (int T = nT - 1; T >= 0; --T) {
        if (T >= 2) asm volatile("s_waitcnt vmcnt(2) lgkmcnt(0)" ::: "memory"); else asm volatile("s_waitcnt vmcnt(0) lgkmcnt(0)" ::: "memory");
        __builtin_amdgcn_s_barrier(); asm volatile("" ::: "memory");
        if (T >= 3) FX_DMA(T - 3);
        if (T <= Tl) {
            if (T == Tl) FX_RDK(T);
            FX_RDC(T);
            f32x16 s0 = c0, s1 = c1;
#pragma unroll
            for (int d0 = 0; d0 < 4; ++d0) { s0 = __builtin_amdgcn_mfma_f32_32x32x16_bf16(kf[d0], qf[d0], s0, 0, 0, 0); s1 = __builtin_amdgcn_mfma_f32_32x32x16_bf16(kf[4 + d0], qf[d0], s1, 0, 0, 0); }
            FX_RDK(T - 1);
            if (T == Tl) { const int kb = 64 * T - 256 * qb;
#pragma unroll
                for (int r = 0; r < 16; ++r) { if (kb + ATT_KEYREL(r, hi) > qrow) s0[r] = NEG; if (kb + 32 + ATT_KEYREL(r, hi) > qrow) s1[r] = NEG; } }
            pv8(S, pprev, vprev);
            FX_RDV(T);
            float ma = __builtin_fmaxf(__builtin_fmaxf(s0[0], s0[1]), s0[2]), mb = __builtin_fmaxf(__builtin_fmaxf(s1[0], s1[1]), s1[2]);
            ma = __builtin_fmaxf(ma, s0[3]); mb = __builtin_fmaxf(mb, s1[3]);
#pragma unroll
            for (int r = 4; r < 16; r += 2) { ma = __builtin_fmaxf(__builtin_fmaxf(ma, s0[r]), s0[r + 1]); mb = __builtin_fmaxf(__builtin_fmaxf(mb, s1[r]), s1[r + 1]); }
            float mx = __builtin_fmaxf(ma, mb); mx = __builtin_fmaxf(mx, __shfl_xor(mx, 32));
            const float mnew = __builtin_fmaxf(S.m, mx), alpha = __builtin_amdgcn_exp2f(S.m - mnew); S.m = mnew;
            s0 = s0 - mnew; s1 = s1 - mnew;
#pragma unroll
            for (int r = 0; r < 16; ++r) { s0[r] = __builtin_amdgcn_exp2f(s0[r]); s1[r] = __builtin_amdgcn_exp2f(s1[r]); }
            { const f32x16 t = s0 + s1; float pa = (t[0] + t[1]) + (t[2] + t[3]), pb = (t[4] + t[5]) + (t[6] + t[7]), pc = (t[8] + t[9]) + (t[10] + t[11]), pd = (t[12] + t[13]) + (t[14] + t[15]);
              S.l = S.l * alpha + ((pa + pb) + (pc + pd)); }
            if (__any(alpha != 1.0f)) { S.o0 *= alpha; S.o1 *= alpha; }
            u32x4 w0, w1, w2, w3;
            w0.x = cvtpk(s0[0], s0[1]); w0.y = cvtpk(s0[2], s0[3]); w0.z = cvtpk(s0[4], s0[5]); w0.w = cvtpk(s0[6], s0[7]);
            w1.x = cvtpk(s0[8], s0[9]); w1.y = cvtpk(s0[10], s0[11]); w1.z = cvtpk(s0[12], s0[13]); w1.w = cvtpk(s0[14], s0[15]);
            w2.x = cvtpk(s1[0], s1[1]); w2.y = cvtpk(s1[2], s1[3]); w2.z = cvtpk(s1[4], s1[5]); w2.w = cvtpk(s1[6], s1[7]);
            w3.x = cvtpk(s1[8], s1[9]); w3.y = cvtpk(s1[10], s1[11]); w3.z = cvtpk(s1[12], s1[13]); w3.w = cvtpk(s1[14], s1[15]);
            pprev[0] = __builtin_bit_cast(bf16x8, w0); pprev[1] = __builtin_bit_cast(bf16x8, w1); pprev[2] = __builtin_bit_cast(bf16x8, w2); pprev[3] = __builtin_bit_cast(bf16x8, w3);
        }
    }
    pv8(S, pprev, vprev);
#undef FX_DMA
#undef FX_RDK
#undef FX_RDV
#undef FX_RDC
    const float lt = S.l + __shfl_xor(S.l, 32); const float inv = __builtin_amdgcn_rcpf(lt);
    GAS bf16_t* Op = O + (size_t)(b * 4096 + q0 + r32) * 1024 + h * 64 + 4 * hi;
#pragma unroll
    for (int dh = 0; dh < 2; ++dh)
#pragma unroll
        for (int rg = 0; rg < 4; ++rg) { const f32x16& o = dh ? S.o1 : S.o0; u32x2 w; w.x = cvtpk(o[4 * rg] * inv, o[4 * rg + 1] * inv); w.y = cvtpk(o[4 * rg + 2] * inv, o[4 * rg + 3] * inv);
            *(GAS u32x2*)(Op + 32 * dh + 8 * rg) = w; }
    __builtin_amdgcn_s_setprio(0);
    asm volatile("s_waitcnt lgkmcnt(0)" ::: "memory"); __builtin_amdgcn_s_barrier(); asm volatile("" ::: "memory");
}

__device__ __forceinline__ void attn0_phase(int g, int vcu, const GAS bf16_t* __restrict__ QK, const GAS bf16_t* __restrict__ VT, GAS bf16_t* O, GAS float* LSE, LAS unsigned char* ring, int wid, int lane) {
    const int r32 = lane & 31, hi = lane >> 5, lgd = 2 * g, lgL = 12 - lgd, TLm = (128 >> lgd) - 1;
    const int kap = (r32 & 0x13) | ((r32 & 4) << 1) | ((r32 & 8) >> 1);
    const unsigned ldst = (unsigned)__builtin_amdgcn_readfirstlane((int)((unsigned)(uintptr_t)ring + (unsigned)wid * 1024u));
    for (int su = vcu; su < 256; su += (int)gridDim.x) {
        const int bh = su >> 1, b = bh >> 4, h = bh & 15, half = su & 1;
        const GAS bf16_t* src; size_t tstep;
        if (wid < 4) { src = QK + (size_t)(b * 4096 + kap) * 2048 + 1024 + h * 64 + 8 * hi + 16 * wid; tstep = (size_t)32 * 2048; }
        else { const int f = wid - 4; src = VT + (size_t)(b * 1024 + h * 64 + 32 * (f >> 1) + r32) * 4096 + 8 * hi + 16 * (f & 1); tstep = 32; }
        for (int j = 0; j < 8; ++j) {
            const int rt0 = 64 * half + 8 * j, lt0 = rt0 & TLm;
            const int lo = (j == 0) ? ((lt0 == 0) ? rt0 : rt0 - 4) : rt0;
            asm volatile("s_waitcnt lgkmcnt(0)" ::: "memory"); __builtin_amdgcn_s_barrier(); asm volatile("" ::: "memory");
            for (int gt = lo; gt < rt0 + 8; ++gt) glds16(src + (size_t)gt * tstep, ldst + (unsigned)(gt & 15) * 8192u);
            const int rt = rt0 + wid, lt = lt0 + wid, kt0 = (lt >= 4) ? 0 : 4 - lt;
            const int w0 = rt * 32, c = w0 >> lgL, i0 = w0 & ((1 << lgL) - 1);
            const GAS bf16_t* Qp = QK + (size_t)(b * 4096 + w0 + r32) * 2048 + h * 64 + 8 * hi;
            bf16x8 qf[4];
#pragma unroll
            for (int d0 = 0; d0 < 4; ++d0) qf[d0] = *(const GAS bf16x8*)(Qp + 16 * d0);
            const int row = b * 4096 + ((i0 + r32) << lgd) + c;
            GAS bf16_t* Op = O + (size_t)row * 1024 + h * 64 + 4 * hi;
            u32x2 pv[8]; float lp = 0.f;
            if (g > 0) { lp = LSE[(size_t)row * 16 + h];
#pragma unroll
                for (int i = 0; i < 8; ++i) pv[i] = *(const GAS u32x2*)(Op + 32 * (i >> 2) + 8 * (i & 3)); }
            asm volatile("s_waitcnt vmcnt(0)" ::: "memory"); __builtin_amdgcn_s_barrier(); asm volatile("" ::: "memory");
            St S; S.m = NEG; S.l = 0.f; S.o0 = f32x16{}; S.o1 = f32x16{};
#define A0_LDT(KVv, gt_) do { const LAS unsigned char* fb = ring + ((gt_) & 15) * 8192 + lane * 16; \
                _Pragma("unroll") for (int d0 = 0; d0 < 4; ++d0) KVv.k[d0] = *(const LAS bf16x8*)(fb + d0 * 1024); \
                _Pragma("unroll") for (int f = 0; f < 4; ++f) KVv.v[f >> 1][f & 1] = *(const LAS bf16x8*)(fb + 4096 + f * 1024); } while (0)
            if (kt0 == 0) {
                KV ka, kb;
                A0_LDT(ka, rt - 4); A0_LDT(kb, rt - 3);
                { f32x16 st = qk(ka, qf);
#pragma unroll
                  for (int r = 0; r < 16; ++r) if (ATT_KEYREL(r, hi) < r32) st[r] = NEG;
                  upd(S, st, ka); }
                A0_LDT(ka, rt - 2);
                upd64(S, qk(kb, qf), qk(ka, qf), kb, ka);
                A0_LDT(kb, rt - 1); A0_LDT(ka, rt);
                { f32x16 s1 = qk(ka, qf);
#pragma unroll
                  for (int r = 0; r < 16; ++r) if (ATT_KEYREL(r, hi) > r32) s1[r] = NEG;
                  upd64(S, qk(kb, qf), s1, kb, ka); }
            } else {
                for (int kt = kt0; kt < 5; ++kt) { KV ka; A0_LDT(ka, rt - 4 + kt); f32x16 st = qk(ka, qf);
                    if (kt == 4) {
#pragma unroll
                        for (int r = 0; r < 16; ++r) if (ATT_KEYREL(r, hi) > r32) st[r] = NEG; }
                    upd(S, st, ka); }
            }
#undef A0_LDT
            const float lt_ = S.l + __shfl_xor(S.l, 32); float inv = __builtin_amdgcn_rcpf(lt_); float lse = S.m + __builtin_amdgcn_logf(lt_);
            float wprev = 0.f;
            if (g > 0) { const float mn = fmaxf(lp, lse), ea = __builtin_amdgcn_exp2f(lse - mn), eb = __builtin_amdgcn_exp2f(lp - mn), den = ea + eb, rd = __builtin_amdgcn_rcpf(den);
                inv *= ea * rd; wprev = eb * rd; lse = mn + __builtin_amdgcn_logf(den); }
#pragma unroll
            for (int dh = 0; dh < 2; ++dh)
#pragma unroll
                for (int rg = 0; rg < 4; ++rg) { const f32x16& o = dh ? S.o1 : S.o0; float v0 = o[4 * rg] * inv, v1 = o[4 * rg + 1] * inv, v2 = o[4 * rg + 2] * inv, v3 = o[4 * rg + 3] * inv;
                    if (g > 0) { const u32x2 p = pv[4 * dh + rg]; v0 += wprev * bflo(p.x); v1 += wprev * bfhi(p.x); v2 += wprev * bflo(p.y); v3 += wprev * bfhi(p.y); }
                    u32x2 w; w.x = cvtpk(v0, v1); w.y = cvtpk(v2, v3); *(GAS u32x2*)(Op + 32 * dh + 8 * rg) = w; }
            if (hi == 0) LSE[(size_t)row * 16 + h] = lse;
        }
    }
    asm volatile("s_waitcnt lgkmcnt(0)" ::: "memory"); __builtin_amdgcn_s_barrier(); asm volatile("" ::: "memory");
}
}

typedef unsigned short bf16;
typedef float f32x4 __attribute__((ext_vector_type(4)));
typedef unsigned v4u __attribute__((ext_vector_type(4)));
constexpr size_t MiB = 1u << 20;
constexpr size_t WS_ROT = 0, WS_RSP = 256 * 1024, WS_BAR = 768 * 1024, WS_SS = 1 * MiB, WS_LF = 9 * MiB, WS_LSE = 11 * MiB;
constexpr size_t WS_WTA = 16 * MiB, WS_WTAO = 34 * MiB, WS_WTB = 36 * MiB, WS_WTBV = 41 * MiB, WS_WTBO = 43 * MiB, WS_WTGU = 45 * MiB, WS_WTD = 67 * MiB;
constexpr size_t WS_XB = 80 * MiB, WS_O = 144 * MiB, WS_QK = 208 * MiB, WS_VT = 336 * MiB, WS_ACT = 208 * MiB, WS_END = 464 * MiB;
constexpr size_t SZ_WTGU = 11 * MiB, SZ_WTD = (size_t)1024 * 2816 * 2, SZ_SS = 2 * MiB;
constexpr int NWAVES = 8, LDS_BYTES = 147456;
constexpr int NPH = 16;

#define XB_TMO      128
#define XB_XCNT(j)  (256  + 64 * (j))
#define XB_CEN      3400
#define XB_XSUB(j)  (1280 + 64 * (j))
#define XB_XGEN(j)  (2304 + 64 * (j))
#define XB_TOP      3328
#define XB_TOPGEN   3392
#define XCD_BAR_WORDS 3456
#define XB_SPIN_CAP (1u << 18)

__device__ __forceinline__ unsigned xb_ld(unsigned* p)              { return __hip_atomic_load(p, __ATOMIC_RELAXED, __HIP_MEMORY_SCOPE_AGENT); }
__device__ __forceinline__ unsigned xb_add(unsigned* p, unsigned v) { return __hip_atomic_fetch_add(p, v, __ATOMIC_RELAXED, __HIP_MEMORY_SCOPE_AGENT); }
__device__ __forceinline__ unsigned xb_xcc_id() { return (unsigned)__builtin_amdgcn_s_getreg((3 << 11) | 20) & 0xFu; }
#define XB_SPIN(cond, bar) do { unsigned _sp = 0; while (cond) { __builtin_amdgcn_s_sleep(1); \
    if ((++_sp & 255u) == 0u) { if (xb_ld(&(bar)[XB_TMO])) break; if (_sp > XB_SPIN_CAP) { atomicAdd(&(bar)[XB_TMO], 1u); break; } } } } while (0)

struct XcdBarrier {
    unsigned* bar; unsigned x;
    volatile LAS unsigned* st;
};

__device__ __forceinline__ XcdBarrier xcd_barrier_post(unsigned* bar, volatile LAS unsigned* st) {
    XcdBarrier b; b.bar = bar; b.x = xb_xcc_id(); b.st = st;
    if (threadIdx.x == 0) (void)__hip_atomic_fetch_add((unsigned long long*)&bar[XB_CEN + 2 * (b.x >> 3)], 1ull << (8 * (b.x & 7)), __ATOMIC_RELAXED, __HIP_MEMORY_SCOPE_AGENT);
    return b;
}
__device__ __forceinline__ void xcd_barrier_complete(unsigned* bar, unsigned x, unsigned& nloc, unsigned& nx) {
    const unsigned G = gridDim.x * gridDim.y * gridDim.z;
    unsigned sum, cnt, mine, sp = 0u;
    for (;;) {
        sum = 0u; cnt = 0u; mine = 0u;
        const unsigned long long ca = __hip_atomic_load((unsigned long long*)&bar[XB_CEN], __ATOMIC_RELAXED, __HIP_MEMORY_SCOPE_AGENT), cb = __hip_atomic_load((unsigned long long*)&bar[XB_CEN + 2], __ATOMIC_RELAXED, __HIP_MEMORY_SCOPE_AGENT);
#pragma unroll
        for (unsigned j = 0; j < 16; ++j) { const unsigned c = (unsigned)(((j < 8u) ? (ca >> (8u * j)) : (cb >> (8u * (j - 8u)))) & 255ull); sum += c; cnt += (c > 0u) ? 1u : 0u; mine = (j == x) ? c : mine; }
        if (sum == G) break;
        __builtin_amdgcn_s_sleep(1);
        if ((++sp & 255u) == 0u) { if (xb_ld(&bar[XB_TMO])) break; if (sp > XB_SPIN_CAP) { atomicAdd(&bar[XB_TMO], 1u); break; } }
    }
    nloc = mine > 0u ? mine : 1u; nx = cnt > 0u ? cnt : 1u;
}

__device__ __forceinline__ void xcd_barrier(const XcdBarrier& b) {
    asm volatile("s_waitcnt vmcnt(0)" ::: "memory");
    __syncthreads();
    if (threadIdx.x == 0) {
        unsigned* bar = b.bar;
        __builtin_amdgcn_s_waitcnt(0);
        unsigned nloc = b.st[0], nx = b.st[1];
        if (nloc == 0u) { xcd_barrier_complete(bar, b.x, nloc, nx); b.st[0] = nloc; b.st[1] = nx; }
        const unsigned old = xb_add(&bar[XB_XSUB(b.x)], 1u);
        const unsigned gen = old / nloc;
        if (old + 1u == (gen + 1u) * nloc) {
            __builtin_amdgcn_fence(__ATOMIC_RELEASE, "agent");
            asm volatile("s_waitcnt vmcnt(0)" ::: "memory");
            const unsigned og = xb_add(&bar[XB_TOP], 1u);
            const unsigned tg = og / nx;
            if (og + 1u == (tg + 1u) * nx) xb_add(&bar[XB_TOPGEN], 1u);
            else XB_SPIN(xb_ld(&bar[XB_TOPGEN]) == tg, bar);
            __builtin_amdgcn_fence(__ATOMIC_ACQUIRE, "agent");
            xb_add(&bar[XB_XGEN(b.x)], 1u);
            asm volatile("s_waitcnt vmcnt(0)" ::: "memory");
        } else {
            XB_SPIN(xb_ld(&bar[XB_XGEN(b.x)]) == gen, bar);
            __builtin_amdgcn_fence(__ATOMIC_ACQUIRE, "agent");
            asm volatile("s_waitcnt vmcnt(0)" ::: "memory");
        }
    }
    __syncthreads();
}


struct Args {
    const float* x; const float* a_norm; const float* a_w_in; const float* a_w_out; const float* b_norm; const float* b_w_in; const float* b_f; const float* b_w_out;
    const float* ffn_norm; const float* ffn_w_gu; const float* ffn_w_down; const float* final_norm; float* out; unsigned char* ws; int ph_lo, ph_hi;
};

__device__ __forceinline__ unsigned f2bf(float f) { unsigned u = __builtin_bit_cast(unsigned, f); return (u + 0x7fffu + ((u >> 16) & 1u)) >> 16; }
__device__ __forceinline__ unsigned pk2(float lo, float hi) { return pg8::cvt_pk_bf16(lo, hi); }
__device__ __forceinline__ float wave_sum(float v) {
#pragma unroll
    for (int o = 1; o < 64; o <<= 1) v += __shfl_xor(v, o);
    return v;
}
__device__ __forceinline__ void transpose_item(const GAS float* __restrict__ W, int ldw, int k0, int nsrc0, const GAS float* __restrict__ gain, GAS bf16* WT, int Kd, int drow0, LAS float* scr, int lane) {
    float wv[32];
    const GAS float* wp = W + (size_t)(k0 + (lane >> 5)) * ldw + nsrc0 + (lane & 31);
#pragma unroll
    for (int i = 0; i < 32; ++i) wv[i] = wp[(size_t)(2 * i) * ldw];
    const int c = lane & 7;
    f32x4 g0 = {1.f, 1.f, 1.f, 1.f}, g1 = {1.f, 1.f, 1.f, 1.f};
    if (gain) { g0 = *(const GAS f32x4*)(gain + k0 + 8 * c); g1 = *(const GAS f32x4*)(gain + k0 + 8 * c + 4); }
    asm volatile("" :: "v"(wv[0]), "v"(wv[1]), "v"(wv[2]), "v"(wv[3]), "v"(wv[4]), "v"(wv[5]), "v"(wv[6]), "v"(wv[7]), "v"(wv[8]), "v"(wv[9]), "v"(wv[10]), "v"(wv[11]), "v"(wv[12]), "v"(wv[13]), "v"(wv[14]), "v"(wv[15]));
    asm volatile("" :: "v"(wv[16]), "v"(wv[17]), "v"(wv[18]), "v"(wv[19]), "v"(wv[20]), "v"(wv[21]), "v"(wv[22]), "v"(wv[23]), "v"(wv[24]), "v"(wv[25]), "v"(wv[26]), "v"(wv[27]), "v"(wv[28]), "v"(wv[29]), "v"(wv[30]), "v"(wv[31]));
#pragma unroll
    for (int i = 0; i < 32; ++i) scr[(2 * i + (lane >> 5)) * 33 + (lane & 31)] = wv[i];
    asm volatile("s_waitcnt lgkmcnt(0)" ::: "memory");
#pragma unroll
    for (int j = 0; j < 4; ++j) { const int n = (lane >> 3) + 8 * j; const LAS float* s = scr + (8 * c) * 33 + n;
        v4u o; o.x = pk2(s[0 * 33] * g0[0], s[1 * 33] * g0[1]); o.y = pk2(s[2 * 33] * g0[2], s[3 * 33] * g0[3]); o.z = pk2(s[4 * 33] * g1[0], s[5 * 33] * g1[1]); o.w = pk2(s[6 * 33] * g1[2], s[7 * 33] * g1[3]);
        *(GAS v4u*)(WT + (size_t)(drow0 + n) * Kd + k0 + 8 * c) = o; }
    asm volatile("s_waitcnt lgkmcnt(0)" ::: "memory");
}

__device__ __forceinline__ void prologue(const Args& a, GAS unsigned char* ws, int bid, LAS unsigned char* lds, int tid, int lane, int wave) {
    LAS float* scr = (LAS float*)(lds + wave * 16384);
    const int gw = bid * NWAVES + wave, NGW = gridDim.x * NWAVES;
    const int gt = bid * (NWAVES * 64) + tid, NGT = gridDim.x * NWAVES * 64;
    constexpr int I_A = 16 * 288, I_AO = 16 * 32, I_BQK = 16 * 64, I_BV = 16 * 32, I_BO = 16 * 32, I_GU = 16 * 176, I_D = 44 * 32;
    constexpr int NITEMS = I_A + I_AO + I_BQK + I_BV + I_BO + 2 * I_GU + 2 * I_D;
    for (int it = gw; it < NITEMS; it += NGW) {
        int r = it;
        if (r < I_A) { const int kb = r / 288, nb = r % 288; transpose_item((const GAS float*)a.a_w_in, 9216, 64 * kb, 32 * nb, (const GAS float*)a.a_norm, (GAS bf16*)(ws + WS_WTA), 1024, 32 * nb, scr, lane); continue; } r -= I_A;
        if (r < I_AO) { const int kb = r / 32, nb = r % 32; transpose_item((const GAS float*)a.a_w_out, 1024, 64 * kb, 32 * nb, nullptr, (GAS bf16*)(ws + WS_WTAO), 1024, 32 * nb, scr, lane); continue; } r -= I_AO;
        if (r < I_BQK) { const int kb = r / 64, nb = r % 64; transpose_item((const GAS float*)a.b_w_in, 3088, 64 * kb, 32 * nb, (const GAS float*)a.b_norm, (GAS bf16*)(ws + WS_WTB), 1024, 32 * nb, scr, lane); continue; } r -= I_BQK;
        if (r < I_BV) { const int kb = r / 32, nb = r % 32; transpose_item((const GAS float*)a.b_w_in, 3088, 64 * kb, 2048 + 32 * nb, (const GAS float*)a.b_norm, (GAS bf16*)(ws + WS_WTBV), 1024, 32 * nb, scr, lane); continue; } r -= I_BV;
        if (r < I_BO) { const int kb = r / 32, nb = r % 32; transpose_item((const GAS float*)a.b_w_out, 1024, 64 * kb, 32 * nb, nullptr, (GAS bf16*)(ws + WS_WTBO), 1024, 32 * nb, scr, lane); continue; } r -= I_BO;
        if (r < 2 * I_GU) { const int l = r / I_GU, q = r % I_GU, kb = q / 176, nb = q % 176, n0 = 32 * nb;
            const int drow = (n0 < FF) ? (256 * (n0 / 128) + (n0 % 128)) : (256 * ((n0 - FF) / 128) + 128 + ((n0 - FF) % 128));
            transpose_item((const GAS float*)a.ffn_w_gu + (size_t)l * 1024 * 5632, 5632, 64 * kb, n0, (const GAS float*)a.ffn_norm + l * 1024, (GAS bf16*)(ws + WS_WTGU + l * SZ_WTGU), 1024, drow, scr, lane); continue; } r -= 2 * I_GU;
        { const int l = r / I_D, q = r % I_D, kb = q / 32, nb = q % 32;
            transpose_item((const GAS float*)a.ffn_w_down + (size_t)l * 2816 * 1024, 1024, 64 * kb, 32 * nb, nullptr, (GAS bf16*)(ws + WS_WTD + l * SZ_WTD), 2816, 32 * nb, scr, lane); }
    }
    { GAS bf16* wtb = (GAS bf16*)(ws + WS_WTB);
      for (int i = gt; i < 16 * 1024; i += NGT) { const int col = i >> 10, k = i & 1023; wtb[(size_t)(2048 + col) * 1024 + k] = (bf16)f2bf(((const GAS float*)a.b_w_in)[(size_t)k * 3088 + 3072 + col] * ((const GAS float*)a.b_norm)[k]); }
      GAS v4u* z = (GAS v4u*)(wtb + (size_t)2064 * 1024); for (int i = gt; i < 240 * 1024 / 8; i += NGT) z[i] = (v4u){0u, 0u, 0u, 0u}; }
    { GAS float* rot = (GAS float*)(ws + WS_ROT);
      for (int i = gt; i < 4096 * 8; i += NGT) { const int s = i >> 3, d = i & 7; const float invf = exp2f(-(float)d * 0.125f * 18.931568569324174f);
          const float ang = (float)s * invf; const float k = rintf(ang * 0.15915494309189535f); float rr = fmaf(-k, 6.28125f, ang); rr = fmaf(-k, 0.0019353071795864769f, rr);
          rot[2 * i] = __builtin_amdgcn_cosf(rr * 0.15915494309189535f); rot[2 * i + 1] = __builtin_amdgcn_sinf(rr * 0.15915494309189535f); } }
    { GAS bf16* xb = (GAS bf16*)(ws + WS_XB); GAS float* rsp = (GAS float*)(ws + WS_RSP);
      for (int row0 = gw * 4; row0 < MT; row0 += NGW * 4) {
          f32x4 v[4][4]; float sq[4];
#pragma unroll
          for (int q = 0; q < 4; ++q) { const GAS f32x4* xr = (const GAS f32x4*)((const GAS float*)a.x + (size_t)(row0 + q) * 1024) + lane;
#pragma unroll
              for (int j = 0; j < 4; ++j) v[q][j] = xr[64 * j]; }
#pragma unroll
          for (int q = 0; q < 4; ++q) { float s = 0.f;
#pragma unroll
              for (int j = 0; j < 4; ++j) s += (v[q][j][0] * v[q][j][0] + v[q][j][1] * v[q][j][1]) + (v[q][j][2] * v[q][j][2] + v[q][j][3] * v[q][j][3]);
              sq[q] = s; }
#pragma unroll
          for (int o = 1; o < 64; o <<= 1) {
#pragma unroll
              for (int q = 0; q < 4; ++q) sq[q] += __shfl_xor(sq[q], o); }
#pragma unroll
          for (int q = 0; q < 4; ++q) { const int row = row0 + q; const float r = 1.0f / sqrtf(sq[q] * (1.0f / 1024.0f) + RMS_EPS);
              GAS unsigned long long* o8 = (GAS unsigned long long*)(xb + (size_t)row * 1024) + lane;
#pragma unroll
              for (int j = 0; j < 4; ++j) o8[64 * j] = (unsigned long long)pk2(v[q][j][0], v[q][j][1]) | ((unsigned long long)pk2(v[q][j][2], v[q][j][3]) << 32);
              if (lane < 3) { const int lgd = 2 * lane, lgL = 12 - lgd, b = row >> 12, s_ = row & 4095; rsp[(size_t)lane * MT + b * 4096 + ((s_ & ((1 << lgd) - 1)) << lgL) + (s_ >> lgd)] = r; } }
      } }
}

__device__ __forceinline__ void final_norm_phase(const GAS float* fnorm, GAS float* outp, int bid, const GAS bf16* hb, const GAS float* ss, int lane, int wave) {
    const int gw = bid * NWAVES + wave, NGW = gridDim.x * NWAVES;
    f32x4 gn[4];
#pragma unroll
    for (int j = 0; j < 4; ++j) gn[j] = ((const GAS f32x4*)fnorm)[lane + 64 * j];
    for (int row0 = gw * 4; row0 < MT; row0 += NGW * 4) {
        unsigned long long w[4][4]; float r[4];
#pragma unroll
        for (int q = 0; q < 4; ++q) { const GAS unsigned long long* h8 = (const GAS unsigned long long*)(hb + (size_t)(row0 + q) * 1024) + lane;
#pragma unroll
            for (int j = 0; j < 4; ++j) w[q][j] = h8[64 * j]; }
#pragma unroll
        for (int q = 0; q < 4; ++q) { const GAS f32x4* p = (const GAS f32x4*)(ss + (size_t)(row0 + q) * 16); const f32x4 s0 = p[0], s1 = p[1], s2 = p[2], s3 = p[3];
            const float t = ((s0[0] + s0[1]) + (s0[2] + s0[3])) + ((s1[0] + s1[1]) + (s1[2] + s1[3])) + ((s2[0] + s2[1]) + (s2[2] + s2[3])) + ((s3[0] + s3[1]) + (s3[2] + s3[3]));
            r[q] = 1.0f / sqrtf(t * (1.0f / 1024.0f) + RMS_EPS); }
#pragma unroll
        for (int q = 0; q < 4; ++q) { GAS f32x4* o = (GAS f32x4*)(outp + (size_t)(row0 + q) * 1024) + lane;
#pragma unroll
            for (int j = 0; j < 4; ++j) { const unsigned lo = (unsigned)w[q][j], hi = (unsigned)(w[q][j] >> 32);
                const f32x4 v = (f32x4){__uint_as_float(lo << 16), __uint_as_float(lo & 0xffff0000u), __uint_as_float(hi << 16), __uint_as_float(hi & 0xffff0000u)};
                o[64 * j] = v * r[q] * gn[j]; } }
    }
}


__device__ __forceinline__ void fgate_pass(const GAS bf16* hb, const GAS bf16* wf, const GAS float* ss, const GAS float* bf, GAS float* lf, int bid, int wave, int lane) {
    typedef short bf16x8v __attribute__((ext_vector_type(8)));
    const int fr = lane & 15, fq = lane >> 4;
    for (int rb = bid * NWAVES + wave; rb < MT / 16; rb += (int)gridDim.x * NWAVES) {
        const int row = rb * 16 + fr;
        const GAS bf16* ap = hb + (size_t)row * 1024 + 8 * fq; const GAS bf16* bp = wf + (size_t)fr * 1024 + 8 * fq;
        const GAS f32x4* sp = (const GAS f32x4*)(ss + (size_t)row * 16); const f32x4 s0 = sp[0], s1 = sp[1], s2 = sp[2], s3 = sp[3];
        f32x4 acc = {0.f, 0.f, 0.f, 0.f};
#pragma unroll
        for (int kb = 0; kb < 2; ++kb) {
            bf16x8v af[16], wf16[16];
#pragma unroll
            for (int k = 0; k < 16; ++k) { af[k] = *(const GAS bf16x8v*)(ap + 32 * (16 * kb + k)); wf16[k] = *(const GAS bf16x8v*)(bp + 32 * (16 * kb + k)); }
            asm volatile("" :: "v"(af[15]), "v"(wf16[15]));
#pragma unroll
            for (int k = 0; k < 16; ++k) acc = __builtin_amdgcn_mfma_f32_16x16x32_bf16(wf16[k], af[k], acc, 0, 0, 0); }
        const float t = ((s0[0] + s0[1]) + (s0[2] + s0[3])) + ((s1[0] + s1[1]) + (s1[2] + s1[3])) + ((s2[0] + s2[1]) + (s2[2] + s2[3])) + ((s3[0] + s3[1]) + (s3[2] + s3[3]));
        const float r = __builtin_amdgcn_rsqf(t * (1.0f / 1024.0f) + RMS_EPS);
        const f32x4 bv = *(const GAS f32x4*)(bf + 4 * fq); f32x4 o;
#pragma unroll
        for (int j = 0; j < 4; ++j) { const float x = acc[j] * r + bv[j]; const float e = __builtin_amdgcn_exp2f(-fabsf(x) * LOG2E); o[j] = fminf(x, 0.f) * LOG2E - __builtin_amdgcn_logf(1.0f + e); }
        *(GAS f32x4*)(lf + (size_t)row * 16 + 4 * fq) = o;
    }
}

template <class Epi> __device__ __forceinline__ void run_gemm(int tid, int bid, LAS unsigned char* lds, const GAS bf16* A, const GAS bf16* Bt, int Mr, int N, int K, int adil, int bdil, const Epi& E) {
    pg8::Gemm g{A, Bt, Mr, N, K, adil, bdil}; pg8::StaticOrder S; S.init(Mr, N, (int)gridDim.x, bid);
    pg8::gemm_phase<Epi, pg8::StaticOrder, true, true>(lds, g, S, E, tid);
}

#ifndef PHMASK
#define PHMASK 0xffff
#endif
#define PHON(k) (((PHMASK) >> (k)) & 1)
__device__ __forceinline__ unsigned long long stash_ld(LAS unsigned char* lds, int i) { const LAS unsigned* p = (const LAS unsigned*)(lds + 147456 - 128) + 2 * i; const unsigned lo = p[0], hi = p[1];
    return ((unsigned long long)(unsigned)__builtin_amdgcn_readfirstlane((int)hi) << 32) | (unsigned)__builtin_amdgcn_readfirstlane((int)lo); }
__global__ void __launch_bounds__(NWAVES * 64, 2) mega_fwd(Args a) {
    extern __shared__ __attribute__((aligned(16))) unsigned char lds_raw[];
    LAS unsigned char* lds = (LAS unsigned char*)lds_raw;
    cg::grid_group grid = cg::this_grid();

    volatile LAS unsigned* bst = (volatile LAS unsigned*)(lds + 147456 - 64);
    if (threadIdx.x < 2) bst[threadIdx.x] = 0u;
    if (threadIdx.x == 0) { LAS unsigned long long* stash = (LAS unsigned long long*)(lds + 147456 - 128);
        stash[0] = (unsigned long long)(uintptr_t)a.x; stash[1] = (unsigned long long)(uintptr_t)a.b_f; stash[2] = (unsigned long long)(uintptr_t)a.final_norm; stash[3] = (unsigned long long)(uintptr_t)a.out; }
    __syncthreads();
    XcdBarrier xbar = xcd_barrier_post((unsigned*)(a.ws + WS_BAR), bst);
    if (a.ph_hi == -12345) grid.sync();
    {
        int tid = threadIdx.x; asm volatile("" : "+v"(tid));
        const int lane = tid & 63, wave = __builtin_amdgcn_readfirstlane(tid >> 6);
        prologue(a, (GAS unsigned char*)a.ws, (int)blockIdx.x, lds, tid, lane, wave);
        xcd_barrier(xbar);
    }
    for (int ph = (a.ph_lo > 1 ? a.ph_lo : 1); ph < a.ph_hi; ++ph) {
#ifdef REPMASK
        for (int rep = 0; rep < 1 + ((REPMASK >> ph) & 1); ++rep)
#endif
        {
        int tid = threadIdx.x; asm volatile("" : "+v"(tid));
        const int lane = tid & 63, wave = __builtin_amdgcn_readfirstlane(tid >> 6);
        int bid = blockIdx.x; asm volatile("" : "+s"(bid));
        unsigned char* ws0 = a.ws; asm volatile("" : "+s"(ws0));
        GAS unsigned char* ws = (GAS unsigned char*)ws0;
        GAS bf16* XB = (GAS bf16*)(ws + WS_XB); GAS bf16* OB = (GAS bf16*)(ws + WS_O); GAS bf16* QK = (GAS bf16*)(ws + WS_QK); GAS bf16* VT = (GAS bf16*)(ws + WS_VT); GAS bf16* ACT = (GAS bf16*)(ws + WS_ACT);
        GAS float* LSE = (GAS float*)(ws + WS_LSE); GAS float* LF = (GAS float*)(ws + WS_LF);
        if (PHON(1) && (ph == 1 || ph == 2 || ph == 4 || ph == 6)) {
            const int ga = (ph - 2) >> 1, gq = (ph == 1) ? 0 : ga + 1;
            if (ph != 1) { GAS bf16* qk = (ga & 1) ? (GAS bf16*)stash_ld(lds, 3) : QK; GAS bf16* vt = (ga & 1) ? (GAS bf16*)(ws + 400 * MiB) : VT;
                const int G = gridDim.x; const int v = (G % 8 == 0) ? (int)((bid % 8) * (G / 8) + bid / 8) : bid; att::attn0_phase(ga, v, qk, vt, OB, LSE, lds, wave, lane); }
            if (gq < 3) { GAS bf16* qk = (gq & 1) ? (GAS bf16*)stash_ld(lds, 3) : QK; GAS bf16* vt = (gq & 1) ? (GAS bf16*)(ws + 400 * MiB) : VT;
                const int dil = 1 << (2 * gq); const GAS bf16* wt = (const GAS bf16*)(ws + WS_WTA) + (size_t)gq * 3072 * 1024; const GAS float* rsp = (const GAS float*)(ws + WS_RSP) + (size_t)gq * MT;
                { pg8::EpiQK0 E{qk, rsp, (const GAS float*)(ws + WS_ROT), 2 * gq}; run_gemm(tid, bid, lds, XB, wt, MT, 2048, 1024, dil, 1, E); }
                { pg8::EpiVT E{vt, rsp, nullptr}; run_gemm(tid, bid, lds, wt + (size_t)2048 * 1024, XB, 1024, MT, 1024, 1, dil, E); } }
        } else if (PHON(7) && (ph == 7 || ph == 12)) {
            const int l = (ph == 12); const GAS bf16* wt = (const GAS bf16*)(ws + (l ? WS_WTBO : WS_WTAO));
            pg8::EpiRes E{l ? (const GAS float*)nullptr : (const GAS float*)stash_ld(lds, 0), XB, (GAS float*)(ws + WS_SS + (size_t)(2 * l) * SZ_SS)}; run_gemm(tid, bid, lds, OB, wt, MT, 1024, 1024, 1, 1, E);
        } else if (PHON(8) && (ph == 8 || ph == 13)) {
            const int l = (ph == 13); pg8::EpiSwiglu E{ACT, (const GAS float*)(ws + WS_SS + (size_t)(2 * l) * SZ_SS)};
            run_gemm(tid, bid, lds, XB, (const GAS bf16*)(ws + WS_WTGU + l * SZ_WTGU), MT, 5632, 1024, 1, 1, E);
        } else if (PHON(9) && (ph == 9 || ph == 14)) {
            const int l = (ph == 14); pg8::EpiRes E{(const GAS float*)nullptr, XB, (GAS float*)(ws + WS_SS + (size_t)(2 * l + 1) * SZ_SS)};
            run_gemm(tid, bid, lds, ACT, (const GAS bf16*)(ws + WS_WTD + l * SZ_WTD), MT, 1024, 2816, 1, 1, E);
        } else if (PHON(10) && ph == 10) {
            const GAS float* ss = (const GAS float*)(ws + WS_SS + SZ_SS);
            fgate_pass(XB, (const GAS bf16*)(ws + WS_WTB) + (size_t)2048 * 1024, ss, (const GAS float*)stash_ld(lds, 1), LF, bid, wave, lane);
            { pg8::EpiQKB E{QK, ss, (const GAS float*)stash_ld(lds, 1), LF}; run_gemm(tid, bid, lds, XB, (const GAS bf16*)(ws + WS_WTB), MT, 2048, 1024, 1, 1, E); }
            { pg8::EpiVT E{VT, nullptr, ss}; run_gemm(tid, bid, lds, (const GAS bf16*)(ws + WS_WTBV), XB, 1024, MT, 1024, 1, 1, E); }
        } else if (PHON(11) && ph == 11) {
            const int G = gridDim.x; const int v = (G % 8 == 0) ? (int)((bid % 8) * (G / 8) + bid / 8) : bid;
            LAS float* cs = (LAS float*)lds; LAS float* wsum = cs + 4096;
            for (int su = v; su < 256; su += G) {
                const int bh = su >> 1, b = bh >> 4, h = bh & 15, set = su & 1;
                __syncthreads();
                float vl[8]; const GAS float* lp = LF + (size_t)(b * 4096 + 8 * tid) * 16 + h;
#pragma unroll
                for (int i = 0; i < 8; ++i) vl[i] = lp[i * 16];
#pragma unroll
                for (int i = 1; i < 8; ++i) vl[i] += vl[i - 1];
                float xs = vl[7];
#pragma unroll
                for (int o = 1; o < 64; o <<= 1) { const float t = __shfl_up(xs, o); if (lane >= o) xs += t; }
                if (lane == 63) wsum[wave] = xs;
                __syncthreads();
                float off = xs - vl[7];
                for (int w = 0; w < wave; ++w) off += wsum[w];
#pragma unroll
                for (int i = 0; i < 8; ++i) cs[8 * tid + i] = -(vl[i] + off);
                __syncthreads();
                for (int ui = 0; ui < 8; ++ui) { const int k = ui >> 1; const int qb = (ui & 1) ? (15 - 2 * k - set) : (2 * k + set); att::fox_unit3(b, h, qb, QK, VT, OB, cs, lds + 32768, wave, lane); }
            }
        } else if (PHON(15) && ph == 15) {
            final_norm_phase((const GAS float*)stash_ld(lds, 2), (GAS float*)stash_ld(lds, 3), bid, XB, (const GAS float*)(ws + WS_SS + 3 * SZ_SS), lane, wave);
        }
        }
        if (ph + 1 < a.ph_hi && ph != 3 && ph != 5) xcd_barrier(xbar);
    }
}

#ifndef MK_N_LAUNCHES
#define MK_N_LAUNCHES 1
#endif
extern "C" void kernel_launch(void* const* d_in, const int* in_sizes, int n_in, void* d_out, int out_size, void* d_ws, size_t ws_size, hipStream_t stream) {
    static int grid = 0;
    if (grid == 0) {
        if (n_in != 12 || out_size != MT * DM || ws_size < WS_END) { fprintf(stderr, "kernel_launch: unexpected problem (n_in %d out %d ws %zu)\n", n_in, out_size, ws_size); grid = -1; return; }
        int dev = 0, cus = 0, per_cu = 0;
        (void)hipGetDevice(&dev); (void)hipDeviceGetAttribute(&cus, hipDeviceAttributeMultiprocessorCount, dev);
        (void)hipFuncSetAttribute((const void*)mega_fwd, hipFuncAttributeMaxDynamicSharedMemorySize, LDS_BYTES);
        if (hipOccupancyMaxActiveBlocksPerMultiprocessor(&per_cu, (const void*)mega_fwd, NWAVES * 64, LDS_BYTES) != hipSuccess || per_cu < 1) per_cu = 1;
        (void)hipGetLastError();
        grid = cus * per_cu; if (grid <= 0) grid = 256;
    }
    if (grid < 0) return;
    (void)hipMemsetAsync((unsigned char*)d_ws + WS_BAR, 0, XCD_BAR_WORDS * sizeof(unsigned), stream);
    Args a{};
    a.x = (const float*)d_in[0]; a.a_norm = (const float*)d_in[1]; a.a_w_in = (const float*)d_in[2]; a.a_w_out = (const float*)d_in[3]; a.b_norm = (const float*)d_in[4]; a.b_w_in = (const float*)d_in[5];
    a.b_f = (const float*)d_in[6]; a.b_w_out = (const float*)d_in[7]; a.ffn_norm = (const float*)d_in[8]; a.ffn_w_gu = (const float*)d_in[9]; a.ffn_w_down = (const float*)d_in[10]; a.final_norm = (const float*)d_in[11];
    a.out = (float*)d_out; a.ws = (unsigned char*)d_ws;
#if MK_N_LAUNCHES == 1
    a.ph_lo = 0; a.ph_hi = NPH; void* args[] = {&a};
    hipError_t e = hipLaunchCooperativeKernel((const void*)mega_fwd, dim3(grid), dim3(NWAVES * 64), args, LDS_BYTES, stream);
    if (e != hipSuccess) fprintf(stderr, "cooperative launch failed: %s (grid %d)\n", hipGetErrorString(e), grid);
#else
    for (int p = 0; p < NPH; ++p) { a.ph_lo = p; a.ph_hi = p + 1; hipLaunchKernelGGL(mega_fwd, dim3(grid), dim3(NWAVES * 64), LDS_BYTES, stream, a); }
#endif
}
```
